# Optimizing an MI355X kernel written in HIP

```python
import jax, jax.numpy as jnp
from jax import lax
import numpy as np

D_MODEL = 1024
BATCH = 2
SEQ = 8192
DEPTH = 2

CHUNK = 64
SUB_CHUNK = 16
POOL_WIDTH = 512
POOL_GROUPS = 4
POOL_WINDOWS = (2, 4, 8, 16)
POOL_GROUP_DIM = POOL_WIDTH // POOL_GROUPS
HGRN_HEADS = 4
HGRN_EXPAND = 128
HGRN_HEAD_DIM = 128
HGRN_FORGET = HGRN_HEADS * HGRN_EXPAND
HGRN_INPUT = HGRN_HEADS * HGRN_HEAD_DIM
N_BRANCHES = 2
D_IN = POOL_WIDTH + 2 * HGRN_FORGET + 2 * HGRN_INPUT + N_BRANCHES * D_MODEL
D_FF = 2816
EPS = 1e-6

kernel_name = 'hybrid_pool_hgrn2_macaron_encoder'


def rmsnorm(x, g):
    xf = x.astype(jnp.float32)
    y = xf * lax.rsqrt(jnp.mean(xf * xf, axis=-1, keepdims=True) + EPS)
    return (y * g.astype(jnp.float32)).astype(x.dtype)


def swiglu(x, w_gate, w_up, w_down):
    return (jax.nn.silu(x @ w_gate) * (x @ w_up)) @ w_down


def causal_pool_mixer(u, pool_w, pool_scale):
    b_, s_, _ = u.shape
    ug = u.reshape(b_, s_, POOL_GROUPS, POOL_GROUP_DIM)
    cs = jnp.cumsum(ug.astype(jnp.float32), axis=1)
    cs = jnp.pad(cs, ((0, 0), (1, 0), (0, 0), (0, 0)))
    pos = jnp.arange(1, s_ + 1)
    means = []
    for g, w in enumerate(POOL_WINDOWS):
        lo = jnp.maximum(pos - w, 0)
        window_sum = cs[:, 1:, g] - cs[:, lo, g]
        count = (pos - lo).astype(jnp.float32)
        means.append(window_sum / count[None, :, None])
    pooled = jnp.stack(means, axis=2).astype(u.dtype)
    mixed = jnp.einsum('bsgc,gcd->bsgd', pooled - ug, pool_w)
    return mixed.reshape(b_, s_, POOL_WIDTH) * pool_scale


def hgrn2_chunkwise(q, k, v, log_f):
    b_, h_, s_, dk = q.shape
    dv = v.shape[-1]
    n = s_ // CHUNK
    ns = CHUNK // SUB_CHUNK
    qc = q.reshape(b_, h_, n, CHUNK, dk)
    kc = k.reshape(b_, h_, n, CHUNK, dk)
    vc = v.reshape(b_, h_, n, CHUNK, dv)
    b = jnp.cumsum(log_f.reshape(b_, h_, n, CHUNK, dk), axis=3)
    b_last = b[:, :, :, -1]

    k_to_end = kc * jnp.exp(b_last[:, :, :, None] - b)
    u_chunk = jnp.einsum('bhnck,bhncv->bhnkv', k_to_end, vc)
    decay = jnp.exp(b_last)

    def step(state, inp):
        d, u = inp
        return d[..., None] * state + u, state

    s0 = jnp.zeros((b_, h_, dk, dv), q.dtype)
    _, s_prev = lax.scan(step, s0, (jnp.moveaxis(decay, 2, 0), jnp.moveaxis(u_chunk, 2, 0)))
    s_prev = jnp.moveaxis(s_prev, 0, 2)
    o_state = jnp.einsum('bhnck,bhnkv->bhncv', qc * jnp.exp(b), s_prev)

    bs = b.reshape(b_, h_, n, ns, SUB_CHUNK, dk)
    qs = qc.reshape(b_, h_, n, ns, SUB_CHUNK, dk)
    ks = kc.reshape(b_, h_, n, ns, SUB_CHUNK, dk)
    vs = vc.reshape(b_, h_, n, ns, SUB_CHUNK, dv)
    b_ref = jnp.concatenate([jnp.zeros_like(bs[:, :, :, :1, -1]), bs[:, :, :, :-1, -1]], axis=3)
    q_ref = qs * jnp.exp(bs - b_ref[..., None, :])
    sub_id = jnp.arange(CHUNK) // SUB_CHUNK
    earlier = sub_id[None, :] < jnp.arange(ns)[:, None]
    k_exp = jnp.where(earlier[:, :, None],
                      b_ref[:, :, :, :, None, :] - b[:, :, :, None, :, :], -jnp.inf)
    k_ref = kc[:, :, :, None] * jnp.exp(k_exp)
    a_cross = jnp.einsum('bhnitk,bhnisk->bhnits', q_ref, k_ref)
    o_cross = jnp.einsum('bhnits,bhnsv->bhnitv', a_cross, vc)

    tril = jnp.tril(jnp.ones((SUB_CHUNK, SUB_CHUNK), bool))
    rel = jnp.where(tril[:, :, None], bs[..., :, None, :] - bs[..., None, :, :], -jnp.inf)
    a_diag = jnp.sum(qs[..., :, None, :] * ks[..., None, :, :] * jnp.exp(rel), axis=-1)
    o_diag = jnp.einsum('bhnits,bhnisv->bhnitv', a_diag, vs)

    o = o_state + (o_cross + o_diag).reshape(b_, h_, n, CHUNK, dv)
    return o.reshape(b_, h_, s_, dv)


def hybrid_mixer(h, w_in, pool_w, pool_scale, lb, hgrn_norm, w_pool_proj, w_hgrn_proj, w_out):
    b_, s_, _ = h.shape
    z = h @ w_in
    splits = [POOL_WIDTH, POOL_WIDTH + HGRN_FORGET, POOL_WIDTH + 2 * HGRN_FORGET,
              POOL_WIDTH + 2 * HGRN_FORGET + HGRN_INPUT, POOL_WIDTH + 2 * HGRN_FORGET + 2 * HGRN_INPUT]
    u_pool, q_pre, f_pre, i_in, og, gates = jnp.split(z, splits, axis=-1)

    pool_out = causal_pool_mixer(u_pool, pool_w, pool_scale)

    def heads(t, d):
        return t.reshape(b_, s_, HGRN_HEADS, d).transpose(0, 2, 1, 3).astype(jnp.float32)

    fz = heads(f_pre, HGRN_EXPAND)
    lbh = lb.astype(jnp.float32).reshape(HGRN_HEADS, 1, HGRN_EXPAND)
    log_f = jnp.logaddexp(jnp.log(lbh), jnp.log1p(-lbh) + jax.nn.log_sigmoid(fz))
    k = (1.0 - lbh) * jax.nn.sigmoid(-fz)
    q = jax.nn.silu(heads(q_pre, HGRN_EXPAND))
    v = heads(i_in, HGRN_HEAD_DIM)
    o = hgrn2_chunkwise(q, k, v, log_f)
    o = o * lax.rsqrt(jnp.mean(o * o, axis=-1, keepdims=True) + EPS)
    o = o.transpose(0, 2, 1, 3).reshape(b_, s_, HGRN_INPUT) * hgrn_norm.astype(jnp.float32)
    hgrn_out = (o * jax.nn.silu(og.astype(jnp.float32))).astype(h.dtype)

    g = jax.nn.sigmoid(gates).reshape(b_, s_, N_BRANCHES, D_MODEL)
    merged = g[:, :, 0] * (pool_out @ w_pool_proj) + g[:, :, 1] * (hgrn_out @ w_hgrn_proj)
    return merged @ w_out


def setup_inputs(seed: int = 0) -> dict:
    key = jax.random.key(seed)
    ks = jax.random.split(key, 20)

    def nrm(k, shape, fan_in):
        return jax.random.normal(k, shape, jnp.float32) * fan_in ** -0.5

    def gain(k, shape):
        return 1.0 + 0.05 * jax.random.normal(k, shape, jnp.float32)

    L, D = DEPTH, D_MODEL
    return {
        'x': jax.random.normal(ks[0], (BATCH, SEQ, D), jnp.float32),
        'ffn1_norm': gain(ks[1], (L, D)),
        'ffn1_w_gate': nrm(ks[2], (L, D, D_FF), D),
        'ffn1_w_up': nrm(ks[3], (L, D, D_FF), D),
        'ffn1_w_down': nrm(ks[4], (L, D_FF, D), D_FF),
        'mix_norm': gain(ks[5], (L, D)),
        'w_in': nrm(ks[6], (L, D, D_IN), D),
        'pool_w': nrm(ks[7], (L, POOL_GROUPS, POOL_GROUP_DIM, POOL_GROUP_DIM), POOL_GROUP_DIM),
        'pool_scale': gain(ks[8], (L, POOL_WIDTH)),
        'lb_logits': 0.5 * jax.random.normal(ks[9], (L, HGRN_FORGET), jnp.float32),
        'hgrn_norm': gain(ks[10], (L, HGRN_INPUT)),
        'w_pool_proj': nrm(ks[11], (L, POOL_WIDTH, D), POOL_WIDTH),
        'w_hgrn_proj': nrm(ks[12], (L, HGRN_INPUT, D), HGRN_INPUT),
        'w_out': nrm(ks[13], (L, D, D), D),
        'ffn2_norm': gain(ks[14], (L, D)),
        'ffn2_w_gate': nrm(ks[15], (L, D, D_FF), D),
        'ffn2_w_up': nrm(ks[16], (L, D, D_FF), D),
        'ffn2_w_down': nrm(ks[17], (L, D_FF, D), D_FF),
        'final_norm': gain(ks[18], (D,)),
    }


def reference(x, ffn1_norm, ffn1_w_gate, ffn1_w_up, ffn1_w_down, mix_norm, w_in, pool_w,
              pool_scale, lb_logits, hgrn_norm, w_pool_proj, w_hgrn_proj, w_out,
              ffn2_norm, ffn2_w_gate, ffn2_w_up, ffn2_w_down, final_norm):
    lb_all = jnp.cumsum(jax.nn.softmax(lb_logits.astype(jnp.float32), axis=0), axis=0)
    lb_all = lb_all - lb_all[:1]
    for l in range(DEPTH):
        x = x + 0.5 * swiglu(rmsnorm(x, ffn1_norm[l]), ffn1_w_gate[l], ffn1_w_up[l], ffn1_w_down[l])
        h = rmsnorm(x, mix_norm[l])
        x = x + hybrid_mixer(h, w_in[l], pool_w[l], pool_scale[l], lb_all[l], hgrn_norm[l],
                             w_pool_proj[l], w_hgrn_proj[l], w_out[l])
        x = x + 0.5 * swiglu(rmsnorm(x, ffn2_norm[l]), ffn2_w_gate[l], ffn2_w_up[l], ffn2_w_down[l])
    return rmsnorm(x, final_norm)
```

```cpp
#include <hip/hip_runtime.h>
#include <cstdio>
#include <cstdint>

#ifndef MK_PER_PHASE
#define MK_PER_PHASE 0
#endif

namespace pg8 {
#define PG8_LAS __attribute__((address_space(3)))
typedef unsigned short bf16_t;
typedef short bf16x8 __attribute__((ext_vector_type(8)));
typedef float f32x4 __attribute__((ext_vector_type(4)));
typedef unsigned u32x4 __attribute__((ext_vector_type(4)));
typedef unsigned u32x2 __attribute__((ext_vector_type(2)));
constexpr int BM = 256, BK = 64, HALF = 128, HTB = HALF * BK * 2  , STAGE_BYTES = 8 * HTB, NXCD = 8, WGM = 8;

__host__ __device__ __forceinline__ int lds_byte(int r, int c) { const int st = (r >> 4) * 2 + (c >> 5), rr = r & 15, cc = c & 31, ob = rr * 64 + cc * 2; return st * 1024 + (ob ^ (((ob >> 9) & 1) << 5)); }
__host__ __device__ __forceinline__ void stage_rc(int b, int& R, int& C) { const int st = b / 1024, sb = b % 1024, swz = sb ^ (((sb >> 9) & 1) << 5); R = (st >> 1) * 16 + swz / 64; C = (st & 1) * 32 + (swz % 64) / 2; }
__host__ __device__ __forceinline__ int perm32(int rho) { const int n = rho >> 4, i = rho & 15; return 8 * (i >> 2) + 4 * n + (i & 3); }

struct Unit { int pm, pn, kind; const char* A; const char* B; };

struct TileOrder {
    int nM, nN, nwg, G, c;
    __host__ __device__ void init(int M, int N, int G_, int c_) { nM = M / BM; nN = N / BM; nwg = nM * nN; G = G_; c = c_; }
    __host__ __device__ bool tile(int i, int& pm, int& pn) const {
        const long L = (long)i * G + c; if (L >= nwg) return false;
        int wgid = (int)L; { const int q = nwg / NXCD, r = nwg % NXCD, xcd = wgid % NXCD, off = wgid / NXCD; wgid = (xcd < r ? xcd * (q + 1) : r * (q + 1) + (xcd - r) * q) + off; }
        const int nig = WGM * nN, gid = wgid / nig, fm = gid * WGM, gsz = (nM - fm) < WGM ? (nM - fm) : WGM;
        pm = fm + ((wgid % nig) % gsz); pn = (wgid % nig) / gsz; return true;
    }
};
struct StaticOrder {
    TileOrder T; const char* A; const char* Bt; size_t tstep;
    __device__ void init(const void* A_, const void* Bt_, int M, int N, int K, int G, int c) { T.init(M, N, G, c); A = (const char*)A_; Bt = (const char*)Bt_; tstep = (size_t)BM * K * 2; }
    __device__ __forceinline__ bool next(int i, Unit& u) const { if (!T.tile(i, u.pm, u.pn)) return false; u.kind = 0; u.A = A + (size_t)u.pm * tstep; u.B = Bt + (size_t)u.pn * tstep; return true; }
};
struct PairOrder {
    TileOrder T; const char *A0, *B0, *A1, *B1; size_t tstep;
    __device__ void init(const void* A0_, const void* B0_, const void* A1_, const void* B1_, int M, int N, int K, int G, int c) { T.init(M, N, G, c); A0 = (const char*)A0_; B0 = (const char*)B0_; A1 = (const char*)A1_; B1 = (const char*)B1_; tstep = (size_t)BM * K * 2; }
    __device__ __forceinline__ bool next(int i, Unit& u) const { if (i >= 2) return false; if (!T.tile(0, u.pm, u.pn)) return false; u.kind = i;
        u.A = (i == 0 ? A0 : A1) + (size_t)u.pm * tstep; u.B = (i == 0 ? B0 : B1) + (size_t)u.pn * tstep; return true; }
};

__device__ __forceinline__ unsigned cvt_pk_bf16(float lo, float hi) { unsigned r; asm volatile("v_cvt_pk_bf16_f32 %0, %1, %2" : "=v"(r) : "v"(lo), "v"(hi)); return r; }

template <class Epi, class Sched, bool ALIGN_EPI = false, bool SP2 = false>
__device__ __forceinline__ void gemm_phase(PG8_LAS unsigned char* lds, const int K, const Sched& S, const Epi& E) {
    int tid_ = threadIdx.x; asm volatile("" : "+v"(tid_));
    const int tid = tid_, wid = __builtin_amdgcn_readfirstlane(tid >> 6), lane = tid & 63, wr = wid >> 2, wc = wid & 3, fr = lane & 15, fq = lane >> 4;
    const int nt = K / BK;
    unsigned voffA[2], voffB[2];
#pragma unroll
    for (int i = 0; i < 2; ++i) { int R, C; stage_rc(tid * 16 + i * 8192, R, C); const int Rb = Epi::PERM ? ((R & ~31) + perm32(R & 31)) : R;
        voffA[i] = (unsigned)(R * K + C) * 2u; voffB[i] = (unsigned)(Rb * K + C) * 2u; }
    const size_t kstep = (size_t)(BK * 2);
    const size_t hstep = (size_t)HALF * K * 2;
    const unsigned ldsw = (unsigned)wid * 1024u;
    const int aoff = lds_byte(wr * 64 + fr, fq * 8), boff = lds_byte(wc * 32 + fr, fq * 8);
#define PG8_SA(b, h) (((b) * 2 + (h)) * HTB)
#define PG8_SB(b, h) ((4 + (b) * 2 + (h)) * HTB)
#define PG8_STAGE(bufoff, gbase, voff) do { _Pragma("unroll") for (int _i = 0; _i < 2; ++_i) \
        __builtin_amdgcn_global_load_lds((const unsigned*)((const char*)(gbase) + (voff)[_i]), (PG8_LAS unsigned*)(lds + (bufoff) + ldsw + _i * 8192), 16, 0, 0); } while (0)
#define PG8_LDA(dst, b, h) do { _Pragma("unroll") for (int m = 0; m < 4; ++m) _Pragma("unroll") for (int k = 0; k < 2; ++k) dst[m][k] = *(const PG8_LAS bf16x8*)(lds + PG8_SA(b, h) + aoff + m * 2048 + k * 1024); } while (0)
#define PG8_LDB(dst, b, h) do { _Pragma("unroll") for (int n = 0; n < 2; ++n) _Pragma("unroll") for (int k = 0; k < 2; ++k) dst[n][k] = *(const PG8_LAS bf16x8*)(lds + PG8_SB(b, h) + boff + n * 2048 + k * 1024); } while (0)
#define PG8_MMA(ai, bj, At, Bt) do { __builtin_amdgcn_s_setprio(1); _Pragma("unroll") for (int m = 0; m < 4; ++m) _Pragma("unroll") for (int n = 0; n < 2; ++n) _Pragma("unroll") for (int k = 0; k < 2; ++k) \
        acc[ai][bj][m][n] = __builtin_amdgcn_mfma_f32_16x16x32_bf16(Bt[n][k], At[m][k], acc[ai][bj][m][n], 0, 0, 0); __builtin_amdgcn_s_setprio(0); } while (0)
#define PG8_WAIT_V(n) asm volatile("s_waitcnt vmcnt(" #n ")" ::: "memory")
#define PG8_WAIT_L(n) asm volatile("s_waitcnt lgkmcnt(" #n ")" ::: "memory")
#define PG8_BAR __builtin_amdgcn_s_barrier()
#define PG8_SCHED __builtin_amdgcn_sched_barrier(0)
    Unit cur, nxt; int ui = 0;
    if (!S.next(0, cur)) return;
    f32x4 acc[2][2][4][2];
#pragma unroll
    for (int a = 0; a < 2; ++a)
#pragma unroll
        for (int b = 0; b < 2; ++b)
#pragma unroll
            for (int m = 0; m < 4; ++m)
#pragma unroll
                for (int n = 0; n < 2; ++n) acc[a][b][m][n] = (f32x4){0.f, 0.f, 0.f, 0.f};
    bf16x8 At[4][2], B0[2][2], B1[2][2];
    const char* cA = cur.A; const char* cB = cur.B;
    if constexpr (SP2) {
        PG8_STAGE(PG8_SB(0, 0), cB, voffB); PG8_STAGE(PG8_SB(0, 1), cB + hstep, voffB); PG8_STAGE(PG8_SA(0, 0), cA, voffA); PG8_STAGE(PG8_SA(0, 1), cA + hstep, voffA);
        if (wr == 1) PG8_BAR;
        PG8_WAIT_V(2); PG8_BAR;
        PG8_STAGE(PG8_SB(1, 0), cB + kstep, voffB); PG8_STAGE(PG8_SA(1, 0), cA + kstep, voffA); PG8_STAGE(PG8_SB(1, 1), cB + hstep + kstep, voffB);
        PG8_WAIT_V(6); PG8_BAR;
    } else {
        PG8_STAGE(PG8_SB(0, 0), cB, voffB); PG8_STAGE(PG8_SA(0, 0), cA, voffA); PG8_STAGE(PG8_SB(0, 1), cB + hstep, voffB); PG8_STAGE(PG8_SA(0, 1), cA + hstep, voffA);
        if (wr == 1) PG8_BAR;
        PG8_WAIT_V(4); PG8_BAR;
        PG8_STAGE(PG8_SB(1, 0), cB + kstep, voffB); PG8_STAGE(PG8_SA(1, 0), cA + kstep, voffA); PG8_STAGE(PG8_SB(1, 1), cB + hstep + kstep, voffB);
        PG8_WAIT_V(6); PG8_BAR;
    }
    for (;;) {
        const bool has_next = S.next(ui + 1, nxt);
        const char* nA = has_next ? nxt.A : cA; const char* nB = has_next ? nxt.B : cB;
        for (int t = 0; t < nt; t += 2) {
            const bool last = (t == nt - 2);
            const char* a1 = cA + (size_t)(t + 1) * kstep;
            const char* a2 = last ? nA : cA + (size_t)(t + 2) * kstep; const char* b2 = last ? nB : cB + (size_t)(t + 2) * kstep;
            const char* a3 = a2 + kstep; const char* b3 = b2 + kstep;
            if constexpr (SP2) {
            PG8_LDB(B0, 0, 0); PG8_LDB(B1, 0, 1); PG8_SCHED; PG8_LDA(At, 0, 0); PG8_STAGE(PG8_SA(1, 1), a1 + hstep, voffA);
            PG8_WAIT_V(8); PG8_WAIT_L(0); PG8_BAR; PG8_MMA(0, 0, At, B0); PG8_MMA(0, 1, At, B1); PG8_BAR; PG8_SCHED;
            PG8_LDA(At, 0, 1); PG8_STAGE(PG8_SB(0, 0), b2, voffB); PG8_STAGE(PG8_SB(0, 1), b2 + hstep, voffB); PG8_STAGE(PG8_SA(0, 0), a2, voffA);
            PG8_WAIT_V(8); PG8_WAIT_L(0); PG8_BAR; PG8_MMA(1, 0, At, B0); PG8_MMA(1, 1, At, B1); PG8_BAR; PG8_SCHED;
            PG8_LDB(B0, 1, 0); PG8_LDB(B1, 1, 1); PG8_SCHED; PG8_LDA(At, 1, 0); PG8_STAGE(PG8_SA(0, 1), a2 + hstep, voffA);
            PG8_WAIT_V(8); PG8_WAIT_L(0); PG8_BAR; PG8_MMA(0, 0, At, B0); PG8_MMA(0, 1, At, B1); PG8_BAR; PG8_SCHED;
            PG8_LDA(At, 1, 1); PG8_STAGE(PG8_SB(1, 0), b3, voffB); PG8_STAGE(PG8_SB(1, 1), b3 + hstep, voffB); PG8_STAGE(PG8_SA(1, 0), a3, voffA);
            PG8_WAIT_V(8); PG8_WAIT_L(0); PG8_BAR; PG8_MMA(1, 0, At, B0); PG8_MMA(1, 1, At, B1); PG8_BAR; PG8_SCHED;
            } else {
            PG8_LDB(B0, 0, 0); PG8_SCHED; PG8_LDA(At, 0, 0); PG8_STAGE(PG8_SA(1, 1), a1 + hstep, voffA);
            PG8_WAIT_L(8); PG8_BAR; PG8_WAIT_L(0); PG8_MMA(0, 0, At, B0); PG8_BAR; PG8_SCHED;
            PG8_LDB(B1, 0, 1); PG8_STAGE(PG8_SB(0, 0), b2, voffB);
            PG8_BAR; PG8_WAIT_L(0); PG8_MMA(0, 1, At, B1); PG8_BAR;
            PG8_LDA(At, 0, 1); PG8_STAGE(PG8_SA(0, 0), a2, voffA);
            PG8_BAR; PG8_WAIT_L(0); PG8_MMA(1, 0, At, B0); PG8_BAR; PG8_SCHED;
            PG8_STAGE(PG8_SB(0, 1), b2 + hstep, voffB);
            PG8_WAIT_V(6); PG8_BAR; PG8_MMA(1, 1, At, B1); PG8_BAR;
            PG8_LDB(B0, 1, 0); PG8_SCHED; PG8_LDA(At, 1, 0); PG8_STAGE(PG8_SA(0, 1), a2 + hstep, voffA);
            PG8_WAIT_L(8); PG8_BAR; PG8_WAIT_L(0); PG8_MMA(0, 0, At, B0); PG8_BAR; PG8_SCHED;
            PG8_LDB(B1, 1, 1); PG8_STAGE(PG8_SB(1, 0), b3, voffB);
            PG8_BAR; PG8_WAIT_L(0); PG8_MMA(0, 1, At, B1); PG8_BAR;
            PG8_LDA(At, 1, 1); PG8_STAGE(PG8_SA(1, 0), a3, voffA);
            PG8_BAR; PG8_WAIT_L(0); PG8_MMA(1, 0, At, B0); PG8_BAR; PG8_SCHED;
            PG8_STAGE(PG8_SB(1, 1), b3 + hstep, voffB);
            PG8_WAIT_V(6); PG8_BAR; PG8_MMA(1, 1, At, B1); PG8_BAR;
            }
        }
        if constexpr (ALIGN_EPI) { if (wr == 0) PG8_BAR; }
        if constexpr (!Epi::AFTER_DRAIN) { E(acc, cur, wr, wc, fr, fq); }
        if (!has_next) break;
#pragma unroll
        for (int a = 0; a < 2; ++a)
#pragma unroll
            for (int b = 0; b < 2; ++b)
#pragma unroll
                for (int m = 0; m < 4; ++m)
#pragma unroll
                    for (int n = 0; n < 2; ++n) acc[a][b][m][n] = (f32x4){0.f, 0.f, 0.f, 0.f};
        cur = nxt; cA = nA; cB = nB; ++ui;
        if constexpr (ALIGN_EPI) { if (wr == 1) PG8_BAR; }
    }
    PG8_WAIT_V(0);
    if constexpr (!ALIGN_EPI) { if (wr == 0) PG8_BAR; }
    PG8_BAR;
    if constexpr (Epi::AFTER_DRAIN) { E.fused(acc, cur, wr, wc, fr, fq, lds, wid, lane); }
#undef PG8_SA
#undef PG8_SB
#undef PG8_STAGE
#undef PG8_LDA
#undef PG8_LDB
#undef PG8_MMA
#undef PG8_WAIT_V
#undef PG8_WAIT_L
#undef PG8_BAR
#undef PG8_SCHED
}
}

constexpr int NWAVES = 8;
constexpr int BATCH = 2, SEQ = 8192, D = 1024, DEPTH = 2, FF = 2816, DIN = 4608, PW = 512, HG = 512, NH = 4, HD = 128;
constexpr int M = BATCH * SEQ;
constexpr float EPS = 1e-6f;

constexpr size_t MiB = 1u << 20;
constexpr size_t WS_CTL = 0, CTL_ZERO_BYTES = 1 * MiB;
constexpr size_t WS_SS = 1 * MiB;
constexpr size_t WS_WGU1 = 2 * MiB;
constexpr size_t WS_WD1 = WS_WGU1 + 11 * MiB;
constexpr size_t WS_WIN = WS_WD1 + 11 * MiB / 2;
constexpr size_t WS_WPA = WS_WIN + 9 * MiB;
constexpr size_t WS_WPB = WS_WPA + 1 * MiB;
constexpr size_t WS_WOUT = WS_WPB + 1 * MiB;
constexpr size_t WS_WGU2 = WS_WOUT + 2 * MiB;
constexpr size_t WS_WD2 = WS_WGU2 + 11 * MiB;
constexpr size_t WS_POOLW = WS_WD2 + 11 * MiB / 2;
constexpr size_t WS_XB = 49 * MiB;
constexpr size_t WS_ACT = 81 * MiB;
constexpr size_t WS_UPOOL = 81 * MiB, WS_Q = 97 * MiB, WS_F = 113 * MiB, WS_V = 129 * MiB, WS_OG = 145 * MiB, WS_GATES = 161 * MiB, WS_POOLOUT = 225 * MiB;
constexpr size_t WS_HOUT = WS_UPOOL;
constexpr size_t WS_MERGED = WS_Q;
constexpr size_t WS_END = 241 * MiB;
static_assert(WS_POOLW + 4 * 128 * 128 * 2 <= WS_XB, "weights region");
static_assert(WS_ACT + (size_t)M * FF * 2 <= 256 * MiB, "act region");

constexpr int CW_BAR = 4096;
constexpr int LDS_BYTES = 147456;
constexpr int RING_OFF = 0, RING_BYTES = 131072, LDSCTL_OFF = RING_BYTES, MISC_OFF = LDSCTL_OFF + 320;

#define GAS __attribute__((address_space(1)))
#define LAS __attribute__((address_space(3)))
typedef unsigned short bf16;
typedef unsigned v4u __attribute__((ext_vector_type(4)));
typedef unsigned v2u __attribute__((ext_vector_type(2)));
typedef float f32x4 __attribute__((ext_vector_type(4)));
typedef GAS unsigned gu32;
#define RLX_AGENT __ATOMIC_RELAXED, __HIP_MEMORY_SCOPE_AGENT
#define LDS_WAIT() asm volatile("s_waitcnt lgkmcnt(0)" ::: "memory")
#define VM_WAIT() asm volatile("s_waitcnt vmcnt(0)" ::: "memory")
__device__ __forceinline__ unsigned f2bf(float f) { unsigned u = __builtin_bit_cast(unsigned, f); return (u + 0x7fffu + ((u >> 16) & 1u)) >> 16; }
__device__ __forceinline__ unsigned pk2(float lo, float hi) { return f2bf(lo) | (f2bf(hi) << 16); }
__device__ __forceinline__ float bf2f(unsigned short b) { return __builtin_bit_cast(float, (unsigned)b << 16); }
__device__ __forceinline__ float bflo(unsigned w) { return __builtin_bit_cast(float, w << 16); }
__device__ __forceinline__ float bfhi(unsigned w) { return __builtin_bit_cast(float, w & 0xffff0000u); }
__device__ __forceinline__ unsigned pkh2(float lo, float hi) { const _Float16 a = (_Float16)lo, b = (_Float16)hi; return (unsigned)__builtin_bit_cast(unsigned short, a) | ((unsigned)__builtin_bit_cast(unsigned short, b) << 16); }
__device__ __forceinline__ float h2f(unsigned short b) { return (float)__builtin_bit_cast(_Float16, b); }
__device__ __forceinline__ float fast_sigmoid(float x) { return __builtin_amdgcn_rcpf(1.0f + __builtin_amdgcn_exp2f(-1.44269504089f * x)); }
__device__ __forceinline__ float fast_silu(float x) { return x * fast_sigmoid(x); }

#define XB_TMO      128
#define XB_XCNT(j)  (256  + 64 * (j))
#define XB_XSUB(j)  (1280 + 64 * (j))
#define XB_XGEN(j)  (2304 + 64 * (j))
#define XB_TOP      3328
#define XB_TOPGEN   3392
#define XCD_BAR_WORDS 3456
#define XB_SPIN_CAP (1u << 20)
__device__ __forceinline__ unsigned xb_ld(unsigned* p)              { return __hip_atomic_load(p, __ATOMIC_RELAXED, __HIP_MEMORY_SCOPE_AGENT); }
__device__ __forceinline__ unsigned xb_add(unsigned* p, unsigned v) { return __hip_atomic_fetch_add(p, v, __ATOMIC_RELAXED, __HIP_MEMORY_SCOPE_AGENT); }
__device__ __forceinline__ unsigned xb_xcc_id() { return (unsigned)__builtin_amdgcn_s_getreg((3 << 11) | 20) & 0xFu; }
#define XB_SPIN(cond, bar) do { unsigned _sp = 0; while (cond) { __builtin_amdgcn_s_sleep(1); \
    if ((++_sp & 255u) == 0u) { if (xb_ld(&(bar)[XB_TMO])) break; if (_sp > XB_SPIN_CAP) { atomicAdd(&(bar)[XB_TMO], 1u); break; } } } } while (0)
struct XcdBarrier { unsigned* bar; unsigned x; volatile LAS unsigned* st; };
__device__ __forceinline__ XcdBarrier xcd_barrier_post(unsigned* bar, volatile LAS unsigned* st) {
    XcdBarrier b; b.bar = bar; b.x = xb_xcc_id(); b.st = st;
    if (threadIdx.x == 0) (void)xb_add(&bar[XB_XCNT(b.x)], 1u);
    return b;
}
__device__ __forceinline__ void xcd_barrier_complete(unsigned* bar, unsigned x, unsigned& nloc, unsigned& nx) {
    const unsigned G = gridDim.x * gridDim.y * gridDim.z;
    unsigned sum, cnt, mine, sp = 0u;
    for (;;) {
        sum = 0u; cnt = 0u; mine = 0u;
#pragma unroll
        for (unsigned j = 0; j < 16; ++j) { const unsigned c = xb_ld(&bar[XB_XCNT(j)]); sum += c; cnt += (c > 0u) ? 1u : 0u; mine = (j == x) ? c : mine; }
        if (sum == G) break;
        __builtin_amdgcn_s_sleep(1);
        if ((++sp & 255u) == 0u) { if (xb_ld(&bar[XB_TMO])) break; if (sp > XB_SPIN_CAP) { atomicAdd(&bar[XB_TMO], 1u); break; } }
    }
    nloc = mine > 0u ? mine : 1u; nx = cnt > 0u ? cnt : 1u;
}
__device__ __forceinline__ void xcd_barrier(const XcdBarrier& b) {
    asm volatile("s_waitcnt vmcnt(0)" ::: "memory");
    __syncthreads();
    if (threadIdx.x == 0) {
        unsigned* bar = b.bar;
        __builtin_amdgcn_s_waitcnt(0);
        unsigned nloc = b.st[0], nx = b.st[1];
        if (nloc == 0u) { xcd_barrier_complete(bar, b.x, nloc, nx); b.st[0] = nloc; b.st[1] = nx; }
        const unsigned old = xb_add(&bar[XB_XSUB(b.x)], 1u);
        const unsigned gen = old / nloc;
        if (old + 1u == (gen + 1u) * nloc) {
            __builtin_amdgcn_fence(__ATOMIC_RELEASE, "agent");
            asm volatile("s_waitcnt vmcnt(0)" ::: "memory");
            const unsigned og = xb_add(&bar[XB_TOP], 1u);
            const unsigned tg = og / nx;
            if (og + 1u == (tg + 1u) * nx) xb_add(&bar[XB_TOPGEN], 1u);
            else XB_SPIN(xb_ld(&bar[XB_TOPGEN]) == tg, bar);
            __builtin_amdgcn_fence(__ATOMIC_ACQUIRE, "agent");
            xb_add(&bar[XB_XGEN(b.x)], 1u);
            asm volatile("s_waitcnt vmcnt(0)" ::: "memory");
        } else {
            XB_SPIN(xb_ld(&bar[XB_XGEN(b.x)]) == gen, bar);
            __builtin_amdgcn_fence(__ATOMIC_ACQUIRE, "agent");
            asm volatile("s_waitcnt vmcnt(0)" ::: "memory");
        }
    }
    __syncthreads();
}

using pg8::Unit; using pg8::cvt_pk_bf16; using pg8::HALF; using pg8::BM;
typedef float f4 __attribute__((ext_vector_type(4)));
typedef float f2v __attribute__((ext_vector_type(2)));

__device__ __forceinline__ void load_rs(const float* ss, int pm, int wr, int fr, float (&rsv)[2][4]) {
#pragma unroll
    for (int ai = 0; ai < 2; ++ai)
#pragma unroll
        for (int m = 0; m < 4; ++m) { const int row = pm * BM + ai * HALF + wr * 64 + m * 16 + fr; const f4 p = *(const f4*)(ss + (size_t)row * 4);
            rsv[ai][m] = 1.0f / sqrtf(((p.x + p.y) + (p.z + p.w)) * (1.0f / D) + EPS); }
}

struct EpiGU {
    static constexpr bool PERM = true, AFTER_DRAIN = false;
    bf16* act; const float* ss;
    __device__ __forceinline__ void operator()(const f4 (&acc)[2][2][4][2], const Unit& u, int wr, int wc, int fr, int fq) const {
        float rsv[2][4]; load_rs(ss, u.pm, wr, fr, rsv);
        const int col0 = u.pn * 128 + wc * 32 + 8 * fq;
#pragma unroll
        for (int ai = 0; ai < 2; ++ai)
#pragma unroll
            for (int m = 0; m < 4; ++m) { const int row = u.pm * BM + ai * HALF + wr * 64 + m * 16 + fr; const float rs = rsv[ai][m];
                float h[8];
#pragma unroll
                for (int n = 0; n < 2; ++n)
#pragma unroll
                    for (int j = 0; j < 4; ++j) { const float g = acc[ai][0][m][n][j] * rs, up = acc[ai][1][m][n][j] * rs; h[n * 4 + j] = fast_silu(g) * up; }
                v4u w; w.x = cvt_pk_bf16(h[0], h[1]); w.y = cvt_pk_bf16(h[2], h[3]); w.z = cvt_pk_bf16(h[4], h[5]); w.w = cvt_pk_bf16(h[6], h[7]);
                *(v4u*)(act + (size_t)row * FF + col0) = w; }
    }
};

struct EpiWin {
    static constexpr bool PERM = true, AFTER_DRAIN = false;
    unsigned char* ws; const float* ss;
    __device__ __forceinline__ void operator()(const f4 (&acc)[2][2][4][2], const Unit& u, int wr, int wc, int fr, int fq) const {
        float rsv[2][4]; load_rs(ss, u.pm, wr, fr, rsv);
        const int pn = u.pn;
        int mode, ld, colt; bf16* base;
        if (pn < 2) { mode = 0; base = (bf16*)(ws + WS_UPOOL); ld = 512; colt = pn * 256; }
        else if (pn < 4) { mode = 1; base = (bf16*)(ws + WS_Q); ld = 512; colt = (pn - 2) * 256; }
        else if (pn < 6) { mode = 2; base = (bf16*)(ws + WS_F); ld = 512; colt = (pn - 4) * 256; }
        else if (pn < 8) { mode = 0; base = (bf16*)(ws + WS_V); ld = 512; colt = (pn - 6) * 256; }
        else if (pn < 10) { mode = 1; base = (bf16*)(ws + WS_OG); ld = 512; colt = (pn - 8) * 256; }
        else { mode = 3; base = (bf16*)(ws + WS_GATES); ld = 2048; colt = (pn - 10) * 256; }
        const int col0 = colt + wc * 32 + 8 * fq;
#pragma unroll
        for (int ai = 0; ai < 2; ++ai)
#pragma unroll
            for (int m = 0; m < 4; ++m) { const int row = u.pm * BM + ai * HALF + wr * 64 + m * 16 + fr; const float rs = rsv[ai][m];
#pragma unroll
                for (int bj = 0; bj < 2; ++bj) {
                    float z[8];
#pragma unroll
                    for (int n = 0; n < 2; ++n)
#pragma unroll
                        for (int j = 0; j < 4; ++j) z[n * 4 + j] = acc[ai][bj][m][n][j] * rs;
                    v4u w;
                    if (mode == 2) { w.x = pkh2(z[0], z[1]); w.y = pkh2(z[2], z[3]); w.z = pkh2(z[4], z[5]); w.w = pkh2(z[6], z[7]); }
                    else {
                        if (mode == 1) {
#pragma unroll
                            for (int e = 0; e < 8; ++e) z[e] = fast_silu(z[e]);
                        } else if (mode == 3) {
#pragma unroll
                            for (int e = 0; e < 8; ++e) z[e] = fast_sigmoid(z[e]);
                        }
                        w.x = cvt_pk_bf16(z[0], z[1]); w.y = cvt_pk_bf16(z[2], z[3]); w.z = cvt_pk_bf16(z[4], z[5]); w.w = cvt_pk_bf16(z[6], z[7]);
                    }
                    *(v4u*)(base + (size_t)row * ld + col0 + bj * HALF) = w; } }
    }
};

struct EpiX {
    static constexpr bool PERM = true, AFTER_DRAIN = true;
    const float* xin; float* xout; bf16* xb; float* ss; float coef;
    __device__ __forceinline__ void fused(f4 (&acc)[2][2][4][2], const Unit& u, int wr, int wc, int fr, int fq, PG8_LAS unsigned char* lds, int wid, int lane) const {
        PG8_LAS float* P = (PG8_LAS float*)lds;
        const int col0 = u.pn * BM + wc * 32 + 8 * fq;
#pragma unroll
        for (int ai = 0; ai < 2; ++ai)
#pragma unroll
            for (int m = 0; m < 4; ++m) { const int rl = ai * HALF + wr * 64 + m * 16 + fr; const size_t off = (size_t)(u.pm * BM + rl) * D + col0;
                float s = 0.f;
#pragma unroll
                for (int bj = 0; bj < 2; ++bj) {
                    const f4 x0 = *(const f4*)(xin + off + bj * HALF), x1 = *(const f4*)(xin + off + bj * HALF + 4);
                    const f4 y0 = x0 + acc[ai][bj][m][0] * coef, y1 = x1 + acc[ai][bj][m][1] * coef;
                    *(f4*)(xout + off + bj * HALF) = y0; *(f4*)(xout + off + bj * HALF + 4) = y1;
                    v4u w; w.x = cvt_pk_bf16(y0[0], y0[1]); w.y = cvt_pk_bf16(y0[2], y0[3]); w.z = cvt_pk_bf16(y1[0], y1[1]); w.w = cvt_pk_bf16(y1[2], y1[3]);
                    *(v4u*)(xb + off + bj * HALF) = w;
                    s += (y0[0] * y0[0] + y0[1] * y0[1]) + (y0[2] * y0[2] + y0[3] * y0[3]) + (y1[0] * y1[0] + y1[1] * y1[1]) + (y1[2] * y1[2] + y1[3] * y1[3]); }
                s += __shfl_xor(s, 16); s += __shfl_xor(s, 32);
                if (fq == 0) P[rl * 4 + wc] = s; }
        asm volatile("s_waitcnt lgkmcnt(0)" ::: "memory"); __builtin_amdgcn_s_barrier(); asm volatile("" ::: "memory");
        const int t = wid * 64 + lane;
        if (t < 256) { const float a = P[t * 4 + 0], b = P[t * 4 + 1], c = P[t * 4 + 2], d = P[t * 4 + 3]; ss[(size_t)(u.pm * BM + t) * 4 + u.pn] = (a + b) + (c + d); }
        asm volatile("s_waitcnt lgkmcnt(0)" ::: "memory"); __builtin_amdgcn_s_barrier(); asm volatile("" ::: "memory");
    }
};

struct EpiProj {
    static constexpr bool PERM = true, AFTER_DRAIN = false;
    const bf16* gates; bf16* merged;
    __device__ __forceinline__ void operator()(const f4 (&acc)[2][2][4][2], const Unit& u, int wr, int wc, int fr, int fq) const {
        const int col0 = u.pn * BM + wc * 32 + 8 * fq;
#pragma unroll
        for (int ai = 0; ai < 2; ++ai)
#pragma unroll
            for (int m = 0; m < 4; ++m) { const int row = u.pm * BM + ai * HALF + wr * 64 + m * 16 + fr;
#pragma unroll
                for (int bj = 0; bj < 2; ++bj) {
                    const v4u g = *(const v4u*)(gates + (size_t)row * 2048 + (u.kind ? 1024 : 0) + col0 + bj * HALF);
                    bf16* mp = merged + (size_t)row * D + col0 + bj * HALF;
                    float y[8];
                    y[0] = bflo(g.x) * acc[ai][bj][m][0][0]; y[1] = bfhi(g.x) * acc[ai][bj][m][0][1]; y[2] = bflo(g.y) * acc[ai][bj][m][0][2]; y[3] = bfhi(g.y) * acc[ai][bj][m][0][3];
                    y[4] = bflo(g.z) * acc[ai][bj][m][1][0]; y[5] = bfhi(g.z) * acc[ai][bj][m][1][1]; y[6] = bflo(g.w) * acc[ai][bj][m][1][2]; y[7] = bfhi(g.w) * acc[ai][bj][m][1][3];
                    if (u.kind) { const v4u t = *(const v4u*)mp;
                        y[0] += bflo(t.x); y[1] += bfhi(t.x); y[2] += bflo(t.y); y[3] += bfhi(t.y); y[4] += bflo(t.z); y[5] += bfhi(t.z); y[6] += bflo(t.w); y[7] += bfhi(t.w); }
                    v4u w; w.x = cvt_pk_bf16(y[0], y[1]); w.y = cvt_pk_bf16(y[2], y[3]); w.z = cvt_pk_bf16(y[4], y[5]); w.w = cvt_pk_bf16(y[6], y[7]);
                    *(v4u*)mp = w; } }
    }
};

__device__ __forceinline__ float wave_sum(float v) {
#pragma unroll
    for (int o = 1; o < 64; o <<= 1) v += __shfl_xor(v, o);
    return v;
}
__device__ __forceinline__ void p0_transpose_item(const float* W, int K, int N, bf16* WT, const float* gain, int rowmode, LAS float* scr, int item, int lane) {
    const int nblk = N / 32, kb = item / nblk, nb = item % nblk, k0 = 64 * kb, n0 = 32 * nb;
#pragma unroll 8
    for (int i = 0; i < 32; ++i) { const int kk = 2 * i + (lane >> 5); float w = W[(size_t)(k0 + kk) * N + n0 + (lane & 31)]; if (gain) w *= gain[k0 + kk]; scr[kk * 33 + (lane & 31)] = w; }
    LDS_WAIT(); asm volatile("" ::: "memory");
    const int c = lane & 7;
#pragma unroll
    for (int j = 0; j < 4; ++j) { const int n = (lane >> 3) + 8 * j; const LAS float* s = scr + (8 * c) * 33 + n;
        v4u o; o.x = pk2(s[0 * 33], s[1 * 33]); o.y = pk2(s[2 * 33], s[3 * 33]); o.z = pk2(s[4 * 33], s[5 * 33]); o.w = pk2(s[6 * 33], s[7 * 33]);
        const int nn = n0 + n; const int orow = rowmode == 0 ? nn : (256 * (nn >> 7) + (nn & 127) + (rowmode == 2 ? 128 : 0));
        *(GAS v4u*)(WT + (size_t)orow * K + k0 + 8 * c) = o; }
    LDS_WAIT(); asm volatile("" ::: "memory");
}

struct Args { const float* in[19]; float* out; unsigned char* ws; int ph_lo, ph_hi; };

__device__ __forceinline__ void convert_weights(const Args& a, int l, LAS unsigned char* lds, int gw, int NGW, int wave, int lane) {
    LAS float* scr = (LAS float*)(lds + RING_OFF + wave * 16384);
    unsigned char* ws = a.ws;
    constexpr int I_GU = (D / 64) * (FF / 32), I_DN = (FF / 64) * (D / 32), I_IN = (D / 64) * (DIN / 32), I_PR = (PW / 64) * (D / 32), I_OUT = (D / 64) * (D / 32), I_PL = 4 * (128 / 64) * (128 / 32);
    constexpr int NITEMS = 4 * I_GU + 2 * I_DN + I_IN + 2 * I_PR + I_OUT + I_PL;
    for (int it = gw; it < NITEMS; it += NGW) {
        int r = it;
        if (r < I_GU) { p0_transpose_item(a.in[2] + (size_t)l * D * FF, D, FF, (bf16*)(ws + WS_WGU1), a.in[1] + l * D, 1, scr, r, lane); continue; } r -= I_GU;
        if (r < I_GU) { p0_transpose_item(a.in[3] + (size_t)l * D * FF, D, FF, (bf16*)(ws + WS_WGU1), a.in[1] + l * D, 2, scr, r, lane); continue; } r -= I_GU;
        if (r < I_GU) { p0_transpose_item(a.in[15] + (size_t)l * D * FF, D, FF, (bf16*)(ws + WS_WGU2), a.in[14] + l * D, 1, scr, r, lane); continue; } r -= I_GU;
        if (r < I_GU) { p0_transpose_item(a.in[16] + (size_t)l * D * FF, D, FF, (bf16*)(ws + WS_WGU2), a.in[14] + l * D, 2, scr, r, lane); continue; } r -= I_GU;
        if (r < I_DN) { p0_transpose_item(a.in[4] + (size_t)l * FF * D, FF, D, (bf16*)(ws + WS_WD1), nullptr, 0, scr, r, lane); continue; } r -= I_DN;
        if (r < I_DN) { p0_transpose_item(a.in[17] + (size_t)l * FF * D, FF, D, (bf16*)(ws + WS_WD2), nullptr, 0, scr, r, lane); continue; } r -= I_DN;
        if (r < I_IN) { p0_transpose_item(a.in[6] + (size_t)l * D * DIN, D, DIN, (bf16*)(ws + WS_WIN), a.in[5] + l * D, 0, scr, r, lane); continue; } r -= I_IN;
        if (r < I_PR) { p0_transpose_item(a.in[11] + (size_t)l * PW * D, PW, D, (bf16*)(ws + WS_WPA), nullptr, 0, scr, r, lane); continue; } r -= I_PR;
        if (r < I_PR) { p0_transpose_item(a.in[12] + (size_t)l * HG * D, HG, D, (bf16*)(ws + WS_WPB), nullptr, 0, scr, r, lane); continue; } r -= I_PR;
        if (r < I_OUT) { p0_transpose_item(a.in[13] + (size_t)l * D * D, D, D, (bf16*)(ws + WS_WOUT), nullptr, 0, scr, r, lane); continue; } r -= I_OUT;
        { const int g = r / 8, rr = r % 8; p0_transpose_item(a.in[7] + (size_t)(l * 4 + g) * 128 * 128, 128, 128, (bf16*)(ws + WS_POOLW) + (size_t)g * 128 * 128, nullptr, 0, scr, rr, lane); }
    }
}

__device__ __forceinline__ void x_to_bf16_ss(const float* x, bf16* xb, float* ss, int gw, int NGW, int lane) {
    for (int m = gw; m < M; m += NGW) {
        const GAS f32x4* xr = (const GAS f32x4*)(x + (size_t)m * D) + lane;
        f32x4 v[4]; float s = 0.f;
#pragma unroll
        for (int j = 0; j < 4; ++j) { v[j] = xr[64 * j]; s += (v[j].x * v[j].x + v[j].y * v[j].y) + (v[j].z * v[j].z + v[j].w * v[j].w); }
        s = wave_sum(s);
        GAS unsigned long long* o8 = (GAS unsigned long long*)(xb + (size_t)m * D) + lane;
#pragma unroll
        for (int j = 0; j < 4; ++j) o8[64 * j] = (unsigned long long)pk2(v[j].x, v[j].y) | ((unsigned long long)pk2(v[j].z, v[j].w) << 32);
        if (lane == 0) *(GAS f32x4*)(ss + (size_t)m * 4) = (f32x4){s, 0.f, 0.f, 0.f};
    }
}

__device__ __forceinline__ void final_norm(float* x, const float* g, int gw, int NGW, int lane) {
    f32x4 gv[4];
#pragma unroll
    for (int j = 0; j < 4; ++j) gv[j] = ((const GAS f32x4*)g)[lane + 64 * j];
    for (int m = gw; m < M; m += NGW) {
        GAS f32x4* xr = (GAS f32x4*)(x + (size_t)m * D) + lane;
        f32x4 v[4]; float s = 0.f;
#pragma unroll
        for (int j = 0; j < 4; ++j) { v[j] = xr[64 * j]; s += (v[j].x * v[j].x + v[j].y * v[j].y) + (v[j].z * v[j].z + v[j].w * v[j].w); }
        const float rs = 1.0f / sqrtf(wave_sum(s) * (1.0f / D) + EPS);
#pragma unroll
        for (int j = 0; j < 4; ++j) xr[64 * j] = v[j] * rs * gv[j];
    }
}

__device__ __forceinline__ float lb_of(const float* lb_logits, int l, int c) {
    if (l == 0) return 0.f;
    const float l0 = lb_logits[c], l1 = lb_logits[HG + c];
    return 1.0f / (1.0f + expf(l0 - l1));
}

__device__ __forceinline__ void pool_naive(const bf16* upool, const float* pool_w  , const float* pool_scale, bf16* pool_out, LAS unsigned char* lds, int vcu, int G, int tid) {
    LAS float* dl = (LAS float*)lds;
    for (int it = vcu; it < (M / 64) * 4; it += G) {
        const int g = it & 3, tt = it >> 2, row0 = tt * 64, w = 2 << g;
        __syncthreads();
        for (int e = tid; e < 64 * 128; e += NWAVES * 64) { const int t = e >> 7, c = e & 127, row = row0 + t, pos = row & (SEQ - 1);
            const int cnt = (pos + 1 < w) ? pos + 1 : w; float s = 0.f;
            for (int k = 0; k < cnt; ++k) s += bf2f(upool[(size_t)(row - k) * PW + g * 128 + c]);
            dl[t * 129 + c] = s / (float)cnt - bf2f(upool[(size_t)row * PW + g * 128 + c]); }
        __syncthreads();
        const int t = tid >> 3, d0 = (tid & 7) * 16;
        float acc[16];
#pragma unroll
        for (int j = 0; j < 16; ++j) acc[j] = 0.f;
        const float* wg = pool_w + (size_t)g * 128 * 128;
        for (int c = 0; c < 128; ++c) { const float dv = dl[t * 129 + c];
#pragma unroll
            for (int j = 0; j < 16; ++j) acc[j] += dv * wg[c * 128 + d0 + j]; }
#pragma unroll
        for (int j = 0; j < 16; ++j) pool_out[(size_t)(row0 + t) * PW + g * 128 + d0 + j] = (bf16)f2bf(acc[j] * pool_scale[g * 128 + d0 + j]);
    }
}

__device__ __forceinline__ void hgrn_naive(const bf16* Q, const bf16* F, const bf16* V, const float* lb_logits, int l, float* O, int gw, int NGW, int lane) {
    for (int item = gw; item < BATCH * NH * HD; item += NGW) {
        const int b = item >> 9, h = (item >> 7) & 3, dv = item & 127, c0 = h * 128 + 2 * lane;
        const float lb0 = lb_of(lb_logits, l, c0), lb1 = lb_of(lb_logits, l, c0 + 1);
        float S0 = 0.f, S1 = 0.f;
        for (int t0 = 0; t0 < SEQ; t0 += 8) {
            unsigned qw[8], fw[8]; unsigned short vw[8];
#pragma unroll
            for (int j = 0; j < 8; ++j) { const size_t row = (size_t)b * SEQ + t0 + j; qw[j] = *(const unsigned*)(Q + row * HG + c0); fw[j] = *(const unsigned*)(F + row * HG + c0); vw[j] = V[row * HG + h * 128 + dv]; }
            float p[8];
#pragma unroll
            for (int j = 0; j < 8; ++j) {
                const float z0 = h2f((unsigned short)(fw[j] & 0xffffu)), z1 = h2f((unsigned short)(fw[j] >> 16)), vv = bf2f(vw[j]);
                const float e0 = expf(-fabsf(z0)), r0 = 1.0f / (1.0f + e0), sg0 = z0 >= 0.f ? r0 : e0 * r0, sm0 = z0 >= 0.f ? e0 * r0 : r0;
                const float e1 = expf(-fabsf(z1)), r1 = 1.0f / (1.0f + e1), sg1 = z1 >= 0.f ? r1 : e1 * r1, sm1 = z1 >= 0.f ? e1 * r1 : r1;
                const float f0 = lb0 + (1.0f - lb0) * sg0, k0 = (1.0f - lb0) * sm0, f1 = lb1 + (1.0f - lb1) * sg1, k1 = (1.0f - lb1) * sm1;
                S0 = f0 * S0 + k0 * vv; S1 = f1 * S1 + k1 * vv;
                p[j] = bflo(qw[j]) * S0 + bfhi(qw[j]) * S1; }
#pragma unroll
            for (int j = 0; j < 8; ++j) p[j] = wave_sum(p[j]);
            if (lane == 0) {
#pragma unroll
                for (int j = 0; j < 8; ++j) O[((size_t)b * SEQ + t0 + j) * HG + h * 128 + dv] = p[j]; }
        }
    }
}

__device__ __forceinline__ void hgrn_norm_gate(const float* O, const bf16* OGs, const float* hn, bf16* hout, int gw, int NGW, int lane) {
    for (int item = gw; item < M * NH; item += NGW) {
        const int row = item >> 2, h = item & 3; const size_t off = (size_t)row * HG + h * 128 + 2 * lane;
        const f2v o = *(const f2v*)(O + off); const unsigned g = *(const unsigned*)(OGs + off);
        const float s = wave_sum(o.x * o.x + o.y * o.y), rs = 1.0f / sqrtf(s * (1.0f / HD) + EPS);
        const float y0 = o.x * rs * hn[h * 128 + 2 * lane] * bflo(g), y1 = o.y * rs * hn[h * 128 + 2 * lane + 1] * bfhi(g);
        *(unsigned*)(hout + off) = pk2(y0, y1);
    }
}

constexpr int PH_PER_LAYER = 10, N_PHASES = 1 + DEPTH * PH_PER_LAYER + 1;

__global__ void __launch_bounds__(NWAVES * 64, 2) enc_fwd(Args args) {
    extern __shared__ __attribute__((aligned(16))) unsigned char lds_raw[];
    LAS unsigned char* lds = (LAS unsigned char*)lds_raw;
    volatile LAS unsigned* MISC = (volatile LAS unsigned*)(lds + MISC_OFF);
    const int G = gridDim.x, bx = blockIdx.x, vcu = (G % 8 == 0) ? (bx % 8) * (G / 8) + bx / 8 : bx;
    unsigned char* const ws = args.ws;
    { const int tid0 = threadIdx.x;
      for (int u = tid0; u < (LDS_BYTES - LDSCTL_OFF) / 4; u += NWAVES * 64) ((LAS unsigned*)(lds + LDSCTL_OFF))[u] = 0u; }
    __syncthreads();
    XcdBarrier bar; bar.bar = (unsigned*)(ws + WS_CTL) + CW_BAR; bar.x = 0; bar.st = nullptr;
#if !MK_PER_PHASE
    bar = xcd_barrier_post((unsigned*)(ws + WS_CTL) + CW_BAR, MISC + 8);
#endif
    const int lo = args.ph_lo, hi = args.ph_hi;
#define IN(k) (lo <= (k) && (k) < hi)
#if MK_PER_PHASE
#define GRID_BAR(k) do { } while (0)
#else
#define GRID_BAR(k) do { if (IN(k) && IN((k) + 1)) xcd_barrier(bar); } while (0)
#endif
#define PH_IDS() int tid = threadIdx.x; asm volatile("" : "+v"(tid)); const int lane = tid & 63, wave = __builtin_amdgcn_readfirstlane(tid >> 6), gw = vcu * NWAVES + wave, NGW = G * NWAVES; (void)lane; (void)gw; (void)NGW
#define WSP(T, off) ((T*)(ws + (off)))

    if (IN(0)) { PH_IDS(); convert_weights(args, 0, lds, gw, NGW, wave, lane); x_to_bf16_ss(args.in[0], WSP(bf16, WS_XB), WSP(float, WS_SS), gw, NGW, lane); }
    GRID_BAR(0);

#pragma unroll 1
    for (int l = 0; l < DEPTH; ++l) {
        const int pb = 1 + l * PH_PER_LAYER;
        if (IN(pb + 0)) { pg8::StaticOrder S; S.init(WSP(bf16, WS_XB), ws + WS_WGU1, M, 2 * FF, D, G, bx); EpiGU E{WSP(bf16, WS_ACT), WSP(float, WS_SS)};
            pg8::gemm_phase<EpiGU, pg8::StaticOrder, true, true>(lds + RING_OFF, D, S, E); }
        GRID_BAR(pb + 0);
        if (IN(pb + 1)) { pg8::StaticOrder S; S.init(WSP(bf16, WS_ACT), ws + WS_WD1, M, D, FF, G, bx); EpiX E{l == 0 ? args.in[0] : args.out, args.out, WSP(bf16, WS_XB), WSP(float, WS_SS), 0.5f};
            pg8::gemm_phase<EpiX, pg8::StaticOrder, false, true>(lds + RING_OFF, FF, S, E); }
        GRID_BAR(pb + 1);
        if (IN(pb + 2)) { pg8::StaticOrder S; S.init(WSP(bf16, WS_XB), ws + WS_WIN, M, DIN, D, G, bx); EpiWin E{ws, WSP(float, WS_SS)};
            pg8::gemm_phase<EpiWin, pg8::StaticOrder, true, true>(lds + RING_OFF, D, S, E); }
        GRID_BAR(pb + 2);
        if (IN(pb + 3)) { PH_IDS();
            pool_naive(WSP(bf16, WS_UPOOL), args.in[7] + (size_t)l * 4 * 128 * 128, args.in[8] + l * PW, WSP(bf16, WS_POOLOUT), lds, vcu, G, tid);
            hgrn_naive(WSP(bf16, WS_Q), WSP(bf16, WS_F), WSP(bf16, WS_V), args.in[9], l, WSP(float, WS_XB), gw, NGW, lane);
        }
        GRID_BAR(pb + 3);
        if (IN(pb + 4)) { PH_IDS(); hgrn_norm_gate(WSP(float, WS_XB), WSP(bf16, WS_OG), args.in[10] + l * HG, WSP(bf16, WS_HOUT), gw, NGW, lane); }
        GRID_BAR(pb + 4);
        if (IN(pb + 5)) { pg8::PairOrder S; S.init(WSP(bf16, WS_POOLOUT), ws + WS_WPA, WSP(bf16, WS_HOUT), ws + WS_WPB, M, D, PW, G, bx); EpiProj E{WSP(bf16, WS_GATES), WSP(bf16, WS_MERGED)};
            pg8::gemm_phase<EpiProj, pg8::PairOrder, true, true>(lds + RING_OFF, PW, S, E); }
        GRID_BAR(pb + 5);
        if (IN(pb + 6)) { pg8::StaticOrder S; S.init(WSP(bf16, WS_MERGED), ws + WS_WOUT, M, D, D, G, bx); EpiX E{args.out, args.out, WSP(bf16, WS_XB), WSP(float, WS_SS), 1.0f};
            pg8::gemm_phase<EpiX, pg8::StaticOrder, false, true>(lds + RING_OFF, D, S, E); }
        GRID_BAR(pb + 6);
        if (IN(pb + 7)) { pg8::StaticOrder S; S.init(WSP(bf16, WS_XB), ws + WS_WGU2, M, 2 * FF, D, G, bx); EpiGU E{WSP(bf16, WS_ACT), WSP(float, WS_SS)};
            pg8::gemm_phase<EpiGU, pg8::StaticOrder, true, true>(lds + RING_OFF, D, S, E); }
        GRID_BAR(pb + 7);
        if (IN(pb + 8)) { pg8::StaticOrder S; S.init(WSP(bf16, WS_ACT), ws + WS_WD2, M, D, FF, G, bx); EpiX E{args.out, args.out, WSP(bf16, WS_XB), WSP(float, WS_SS), 0.5f};
            pg8::gemm_phase<EpiX, pg8::StaticOrder, false, true>(lds + RING_OFF, FF, S, E); }
        GRID_BAR(pb + 8);
        if (IN(pb + 9)) { if (l + 1 < DEPTH) { PH_IDS(); __syncthreads(); convert_weights(args, l + 1, lds, gw, NGW, wave, lane); } }
        GRID_BAR(pb + 9);
    }
    if (IN(N_PHASES - 1)) { PH_IDS(); final_norm(args.out, args.in[18], gw, NGW, lane); }
#undef IN
#undef GRID_BAR
#undef PH_IDS
#undef WSP
}

extern "C" void kernel_launch(void* const* d_in, const int* in_sizes, int n_in, void* d_out, int out_size, void* d_ws, size_t ws_size, hipStream_t stream) {
    static int grid = 0;
    if (grid == 0) {
        if (n_in != 19 || in_sizes[0] != M * D || out_size != M * D || ws_size < WS_END) { fprintf(stderr, "kernel_launch: unexpected shapes (n_in %d, in0 %d, out %d, ws %zu); nothing launched\n", n_in, n_in > 0 ? in_sizes[0] : -1, out_size, ws_size); grid = -1; return; }
        int dev = 0, cus = 0, per_cu = 0;
        if (hipGetDevice(&dev) != hipSuccess || hipDeviceGetAttribute(&cus, hipDeviceAttributeMultiprocessorCount, dev) != hipSuccess) { grid = -1; return; }
        if (hipFuncSetAttribute((const void*)enc_fwd, hipFuncAttributeMaxDynamicSharedMemorySize, LDS_BYTES) != hipSuccess) { fprintf(stderr, "kernel_launch: hipFuncSetAttribute failed\n"); grid = -1; return; }
        if (hipOccupancyMaxActiveBlocksPerMultiprocessor(&per_cu, (const void*)enc_fwd, NWAVES * 64, LDS_BYTES) != hipSuccess || per_cu < 1)
            fprintf(stderr, "kernel_launch: note: occupancy query reports %d workgroups per CU\n", per_cu);
        (void)hipGetLastError();
        grid = cus;
        if (grid != 256) fprintf(stderr, "kernel_launch: %d CUs; this kernel is laid out for 256\n", grid);
    }
    if (grid < 0) return;
    (void)hipMemsetAsync((char*)d_ws + WS_CTL, 0, CTL_ZERO_BYTES, stream);
    Args a{};
    for (int i = 0; i < 19; ++i) a.in[i] = (const float*)d_in[i];
    a.out = (float*)d_out; a.ws = (unsigned char*)d_ws;
#if MK_PER_PHASE
    for (int p = 0; p < N_PHASES; ++p) { a.ph_lo = p; a.ph_hi = p + 1; hipLaunchKernelGGL(enc_fwd, dim3(grid), dim3(NWAVES * 64), LDS_BYTES, stream, a); }
#else
    a.ph_lo = 0; a.ph_hi = N_PHASES;
    hipLaunchKernelGGL(enc_fwd, dim3(grid), dim3(NWAVES * 64), LDS_BYTES, stream, a);
#endif
}
```

```cpp
#include <hip/hip_runtime.h>
#include <cstdio>
#include <cstdint>

#ifndef MK_PER_PHASE
#define MK_PER_PHASE 0
#endif

namespace pg8 {
#define PG8_LAS __attribute__((address_space(3)))
typedef unsigned short bf16_t;
typedef short bf16x8 __attribute__((ext_vector_type(8)));
typedef float f32x4 __attribute__((ext_vector_type(4)));
typedef unsigned u32x4 __attribute__((ext_vector_type(4)));
typedef unsigned u32x2 __attribute__((ext_vector_type(2)));
constexpr int BM = 256, BK = 64, HALF = 128, HTB = HALF * BK * 2  , STAGE_BYTES = 8 * HTB, NXCD = 8, WGM = 8;

__host__ __device__ __forceinline__ int lds_byte(int r, int c) { const int st = (r >> 4) * 2 + (c >> 5), rr = r & 15, cc = c & 31, ob = rr * 64 + cc * 2; return st * 1024 + (ob ^ (((ob >> 9) & 1) << 5)); }
__host__ __device__ __forceinline__ void stage_rc(int b, int& R, int& C) { const int st = b / 1024, sb = b % 1024, swz = sb ^ (((sb >> 9) & 1) << 5); R = (st >> 1) * 16 + swz / 64; C = (st & 1) * 32 + (swz % 64) / 2; }
__host__ __device__ __forceinline__ int perm32(int rho) { const int n = rho >> 4, i = rho & 15; return 8 * (i >> 2) + 4 * n + (i & 3); }

struct Unit { int pm, pn, kind; const char* A; const char* B; };

struct TileOrder {
    int nM, nN, nwg, G, c;
    __host__ __device__ void init(int M, int N, int G_, int c_) { nM = M / BM; nN = N / BM; nwg = nM * nN; G = G_; c = c_; }
    __host__ __device__ bool tile(int i, int& pm, int& pn) const {
        const long L = (long)i * G + c; if (L >= nwg) return false;
        int wgid = (int)L; { const int q = nwg / NXCD, r = nwg % NXCD, xcd = wgid % NXCD, off = wgid / NXCD; wgid = (xcd < r ? xcd * (q + 1) : r * (q + 1) + (xcd - r) * q) + off; }
        const int nig = WGM * nN, gid = wgid / nig, fm = gid * WGM, gsz = (nM - fm) < WGM ? (nM - fm) : WGM;
        pm = fm + ((wgid % nig) % gsz); pn = (wgid % nig) / gsz; return true;
    }
};
struct StaticOrder {
    TileOrder T; const char* A; const char* Bt; size_t tstep;
    __device__ void init(const void* A_, const void* Bt_, int M, int N, int K, int G, int c) { T.init(M, N, G, c); A = (const char*)A_; Bt = (const char*)Bt_; tstep = (size_t)BM * K * 2; }
    __device__ __forceinline__ bool next(int i, Unit& u) const { if (!T.tile(i, u.pm, u.pn)) return false; u.kind = 0; u.A = A + (size_t)u.pm * tstep; u.B = Bt + (size_t)u.pn * tstep; return true; }
};
struct PairOrder {
    TileOrder T; const char *A0, *B0, *A1, *B1; size_t tstep;
    __device__ void init(const void* A0_, const void* B0_, const void* A1_, const void* B1_, int M, int N, int K, int G, int c) { T.init(M, N, G, c); A0 = (const char*)A0_; B0 = (const char*)B0_; A1 = (const char*)A1_; B1 = (const char*)B1_; tstep = (size_t)BM * K * 2; }
    __device__ __forceinline__ bool next(int i, Unit& u) const { if (i >= 2) return false; if (!T.tile(0, u.pm, u.pn)) return false; u.kind = i;
        u.A = (i == 0 ? A0 : A1) + (size_t)u.pm * tstep; u.B = (i == 0 ? B0 : B1) + (size_t)u.pn * tstep; return true; }
};

__device__ __forceinline__ unsigned cvt_pk_bf16(float lo, float hi) { unsigned r; asm volatile("v_cvt_pk_bf16_f32 %0, %1, %2" : "=v"(r) : "v"(lo), "v"(hi)); return r; }

template <class Epi, class Sched, bool ALIGN_EPI = false, bool SP2 = false>
__device__ __forceinline__ void gemm_phase(PG8_LAS unsigned char* lds, const int K, const Sched& S, const Epi& E) {
    int tid_ = threadIdx.x; asm volatile("" : "+v"(tid_));
    const int tid = tid_, wid = __builtin_amdgcn_readfirstlane(tid >> 6), lane = tid & 63, wr = wid >> 2, wc = wid & 3, fr = lane & 15, fq = lane >> 4;
    const int nt = K / BK;
    unsigned voffA[2], voffB[2];
#pragma unroll
    for (int i = 0; i < 2; ++i) { int R, C; stage_rc(tid * 16 + i * 8192, R, C); const int Rb = Epi::PERM ? ((R & ~31) + perm32(R & 31)) : R;
        voffA[i] = (unsigned)(R * K + C) * 2u; voffB[i] = (unsigned)(Rb * K + C) * 2u; }
    const size_t kstep = (size_t)(BK * 2);
    const size_t hstep = (size_t)HALF * K * 2;
    const unsigned ldsw = (unsigned)wid * 1024u;
    const int aoff = lds_byte(wr * 64 + fr, fq * 8), boff = lds_byte(wc * 32 + fr, fq * 8);
#define PG8_SA(b, h) (((b) * 2 + (h)) * HTB)
#define PG8_SB(b, h) ((4 + (b) * 2 + (h)) * HTB)
#define PG8_STAGE(bufoff, gbase, voff) do { _Pragma("unroll") for (int _i = 0; _i < 2; ++_i) \
        __builtin_amdgcn_global_load_lds((const unsigned*)((const char*)(gbase) + (voff)[_i]), (PG8_LAS unsigned*)(lds + (bufoff) + ldsw + _i * 8192), 16, 0, 0); } while (0)
#define PG8_LDA(dst, b, h) do { _Pragma("unroll") for (int m = 0; m < 4; ++m) _Pragma("unroll") for (int k = 0; k < 2; ++k) dst[m][k] = *(const PG8_LAS bf16x8*)(lds + PG8_SA(b, h) + aoff + m * 2048 + k * 1024); } while (0)
#define PG8_LDB(dst, b, h) do { _Pragma("unroll") for (int n = 0; n < 2; ++n) _Pragma("unroll") for (int k = 0; k < 2; ++k) dst[n][k] = *(const PG8_LAS bf16x8*)(lds + PG8_SB(b, h) + boff + n * 2048 + k * 1024); } while (0)
#define PG8_MMA(ai, bj, At, Bt) do { __builtin_amdgcn_s_setprio(1); _Pragma("unroll") for (int m = 0; m < 4; ++m) _Pragma("unroll") for (int n = 0; n < 2; ++n) _Pragma("unroll") for (int k = 0; k < 2; ++k) \
        acc[ai][bj][m][n] = __builtin_amdgcn_mfma_f32_16x16x32_bf16(Bt[n][k], At[m][k], acc[ai][bj][m][n], 0, 0, 0); __builtin_amdgcn_s_setprio(0); } while (0)
#define PG8_WAIT_V(n) asm volatile("s_waitcnt vmcnt(" #n ")" ::: "memory")
#define PG8_WAIT_L(n) asm volatile("s_waitcnt lgkmcnt(" #n ")" ::: "memory")
#define PG8_BAR __builtin_amdgcn_s_barrier()
#define PG8_SCHED __builtin_amdgcn_sched_barrier(0)
    Unit cur, nxt; int ui = 0;
    if (!S.next(0, cur)) return;
    f32x4 acc[2][2][4][2];
#pragma unroll
    for (int a = 0; a < 2; ++a)
#pragma unroll
        for (int b = 0; b < 2; ++b)
#pragma unroll
            for (int m = 0; m < 4; ++m)
#pragma unroll
                for (int n = 0; n < 2; ++n) acc[a][b][m][n] = (f32x4){0.f, 0.f, 0.f, 0.f};
    bf16x8 At[4][2], B0[2][2], B1[2][2];
    const char* cA = cur.A; const char* cB = cur.B;
    if constexpr (SP2) {
        PG8_STAGE(PG8_SB(0, 0), cB, voffB); PG8_STAGE(PG8_SB(0, 1), cB + hstep, voffB); PG8_STAGE(PG8_SA(0, 0), cA, voffA); PG8_STAGE(PG8_SA(0, 1), cA + hstep, voffA);
        if (wr == 1) PG8_BAR;
        PG8_WAIT_V(2); PG8_BAR;
        PG8_STAGE(PG8_SB(1, 0), cB + kstep, voffB); PG8_STAGE(PG8_SA(1, 0), cA + kstep, voffA); PG8_STAGE(PG8_SB(1, 1), cB + hstep + kstep, voffB);
        PG8_WAIT_V(6); PG8_BAR;
    } else {
        PG8_STAGE(PG8_SB(0, 0), cB, voffB); PG8_STAGE(PG8_SA(0, 0), cA, voffA); PG8_STAGE(PG8_SB(0, 1), cB + hstep, voffB); PG8_STAGE(PG8_SA(0, 1), cA + hstep, voffA);
        if (wr == 1) PG8_BAR;
        PG8_WAIT_V(4); PG8_BAR;
        PG8_STAGE(PG8_SB(1, 0), cB + kstep, voffB); PG8_STAGE(PG8_SA(1, 0), cA + kstep, voffA); PG8_STAGE(PG8_SB(1, 1), cB + hstep + kstep, voffB);
        PG8_WAIT_V(6); PG8_BAR;
    }
    for (;;) {
        const bool has_next = S.next(ui + 1, nxt);
        const char* nA = has_next ? nxt.A : cA; const char* nB = has_next ? nxt.B : cB;
        for (int t = 0; t < nt; t += 2) {
            const bool last = (t == nt - 2);
            const char* a1 = cA + (size_t)(t + 1) * kstep;
            const char* a2 = last ? nA : cA + (size_t)(t + 2) * kstep; const char* b2 = last ? nB : cB + (size_t)(t + 2) * kstep;
            const char* a3 = a2 + kstep; const char* b3 = b2 + kstep;
            if constexpr (SP2) {
            PG8_LDB(B0, 0, 0); PG8_LDB(B1, 0, 1); PG8_SCHED; PG8_LDA(At, 0, 0); PG8_STAGE(PG8_SA(1, 1), a1 + hstep, voffA);
            PG8_WAIT_V(8); PG8_WAIT_L(0); PG8_BAR; PG8_MMA(0, 0, At, B0); PG8_MMA(0, 1, At, B1); PG8_BAR; PG8_SCHED;
            PG8_LDA(At, 0, 1); PG8_STAGE(PG8_SB(0, 0), b2, voffB); PG8_STAGE(PG8_SB(0, 1), b2 + hstep, voffB); PG8_STAGE(PG8_SA(0, 0), a2, voffA);
            PG8_WAIT_V(8); PG8_WAIT_L(0); PG8_BAR; PG8_MMA(1, 0, At, B0); PG8_MMA(1, 1, At, B1); PG8_BAR; PG8_SCHED;
            PG8_LDB(B0, 1, 0); PG8_LDB(B1, 1, 1); PG8_SCHED; PG8_LDA(At, 1, 0); PG8_STAGE(PG8_SA(0, 1), a2 + hstep, voffA);
            PG8_WAIT_V(8); PG8_WAIT_L(0); PG8_BAR; PG8_MMA(0, 0, At, B0); PG8_MMA(0, 1, At, B1); PG8_BAR; PG8_SCHED;
            PG8_LDA(At, 1, 1); PG8_STAGE(PG8_SB(1, 0), b3, voffB); PG8_STAGE(PG8_SB(1, 1), b3 + hstep, voffB); PG8_STAGE(PG8_SA(1, 0), a3, voffA);
            PG8_WAIT_V(8); PG8_WAIT_L(0); PG8_BAR; PG8_MMA(1, 0, At, B0); PG8_MMA(1, 1, At, B1); PG8_BAR; PG8_SCHED;
            } else {
            PG8_LDB(B0, 0, 0); PG8_SCHED; PG8_LDA(At, 0, 0); PG8_STAGE(PG8_SA(1, 1), a1 + hstep, voffA);
            PG8_WAIT_L(8); PG8_BAR; PG8_WAIT_L(0); PG8_MMA(0, 0, At, B0); PG8_BAR; PG8_SCHED;
            PG8_LDB(B1, 0, 1); PG8_STAGE(PG8_SB(0, 0), b2, voffB);
            PG8_BAR; PG8_WAIT_L(0); PG8_MMA(0, 1, At, B1); PG8_BAR;
            PG8_LDA(At, 0, 1); PG8_STAGE(PG8_SA(0, 0), a2, voffA);
            PG8_BAR; PG8_WAIT_L(0); PG8_MMA(1, 0, At, B0); PG8_BAR; PG8_SCHED;
            PG8_STAGE(PG8_SB(0, 1), b2 + hstep, voffB);
            PG8_WAIT_V(6); PG8_BAR; PG8_MMA(1, 1, At, B1); PG8_BAR;
            PG8_LDB(B0, 1, 0); PG8_SCHED; PG8_LDA(At, 1, 0); PG8_STAGE(PG8_SA(0, 1), a2 + hstep, voffA);
            PG8_WAIT_L(8); PG8_BAR; PG8_WAIT_L(0); PG8_MMA(0, 0, At, B0); PG8_BAR; PG8_SCHED;
            PG8_LDB(B1, 1, 1); PG8_STAGE(PG8_SB(1, 0), b3, voffB);
            PG8_BAR; PG8_WAIT_L(0); PG8_MMA(0, 1, At, B1); PG8_BAR;
            PG8_LDA(At, 1, 1); PG8_STAGE(PG8_SA(1, 0), a3, voffA);
            PG8_BAR; PG8_WAIT_L(0); PG8_MMA(1, 0, At, B0); PG8_BAR; PG8_SCHED;
            PG8_STAGE(PG8_SB(1, 1), b3 + hstep, voffB);
            PG8_WAIT_V(6); PG8_BAR; PG8_MMA(1, 1, At, B1); PG8_BAR;
            }
        }
        if constexpr (ALIGN_EPI) { if (wr == 0) PG8_BAR; }
        if constexpr (!Epi::AFTER_DRAIN) { E(acc, cur, wr, wc, fr, fq); }
        if (!has_next) break;
#pragma unroll
        for (int a = 0; a < 2; ++a)
#pragma unroll
            for (int b = 0; b < 2; ++b)
#pragma unroll
                for (int m = 0; m < 4; ++m)
#pragma unroll
                    for (int n = 0; n < 2; ++n) acc[a][b][m][n] = (f32x4){0.f, 0.f, 0.f, 0.f};
        cur = nxt; cA = nA; cB = nB; ++ui;
        if constexpr (ALIGN_EPI) { if (wr == 1) PG8_BAR; }
    }
    PG8_WAIT_V(0);
    if constexpr (!ALIGN_EPI) { if (wr == 0) PG8_BAR; }
    PG8_BAR;
    if constexpr (Epi::AFTER_DRAIN) { E.fused(acc, cur, wr, wc, fr, fq, lds, wid, lane); }
#undef PG8_SA
#undef PG8_SB
#undef PG8_STAGE
#undef PG8_LDA
#undef PG8_LDB
#undef PG8_MMA
#undef PG8_WAIT_V
#undef PG8_WAIT_L
#undef PG8_BAR
#undef PG8_SCHED
}
}

constexpr int NWAVES = 8;
constexpr int BATCH = 2, SEQ = 8192, D = 1024, DEPTH = 2, FF = 2816, DIN = 4608, PW = 512, HG = 512, NH = 4, HD = 128;
constexpr int M = BATCH * SEQ;
constexpr float EPS = 1e-6f;

constexpr size_t MiB = 1u << 20;
constexpr size_t WS_CTL = 0, CTL_ZERO_BYTES = 1 * MiB;
constexpr size_t WS_SS = 1 * MiB;
constexpr size_t WS_DEC = WS_SS + 512 * 1024;
constexpr size_t WS_WGU1 = 2 * MiB;
constexpr size_t WS_WD1 = WS_WGU1 + 11 * MiB;
constexpr size_t WS_WIN = WS_WD1 + 11 * MiB / 2;
constexpr size_t WS_WPA = WS_WIN + 9 * MiB;
constexpr size_t WS_WPB = WS_WPA + 1 * MiB;
constexpr size_t WS_WOUT = WS_WPB + 1 * MiB;
constexpr size_t WS_WGU2 = WS_WOUT + 2 * MiB;
constexpr size_t WS_WD2 = WS_WGU2 + 11 * MiB;
constexpr size_t WS_POOLW = WS_WD2 + 11 * MiB / 2;
constexpr size_t WS_XB = 49 * MiB;
constexpr size_t WS_ACT = 81 * MiB;
constexpr size_t WS_UPOOL = 81 * MiB, WS_Q = 97 * MiB, WS_F = 113 * MiB, WS_V = 129 * MiB, WS_OG = 145 * MiB, WS_GATES = 161 * MiB, WS_POOLOUT = 225 * MiB;
constexpr size_t WS_HOUT = WS_UPOOL;
constexpr size_t WS_MERGED = WS_Q;
constexpr size_t WS_END = 241 * MiB;
static_assert(WS_POOLW + 4 * 128 * 128 * 2 <= WS_XB, "weights region");
static_assert(WS_ACT + (size_t)M * FF * 2 <= 256 * MiB, "act region");

constexpr int CW_BAR = 4096;
constexpr int LDS_BYTES = 147456;
constexpr int RING_OFF = 0, RING_BYTES = 131072, LDSCTL_OFF = RING_BYTES, MISC_OFF = LDSCTL_OFF + 320;

#define GAS __attribute__((address_space(1)))
#define LAS __attribute__((address_space(3)))
typedef unsigned short bf16;
typedef unsigned v4u __attribute__((ext_vector_type(4)));
typedef unsigned v2u __attribute__((ext_vector_type(2)));
typedef float f32x4 __attribute__((ext_vector_type(4)));
typedef GAS unsigned gu32;
#define RLX_AGENT __ATOMIC_RELAXED, __HIP_MEMORY_SCOPE_AGENT
#define LDS_WAIT() asm volatile("s_waitcnt lgkmcnt(0)" ::: "memory")
#define VM_WAIT() asm volatile("s_waitcnt vmcnt(0)" ::: "memory")
__device__ __forceinline__ unsigned f2bf(float f) { unsigned u = __builtin_bit_cast(unsigned, f); return (u + 0x7fffu + ((u >> 16) & 1u)) >> 16; }
__device__ __forceinline__ unsigned pk2(float lo, float hi) { return f2bf(lo) | (f2bf(hi) << 16); }
__device__ __forceinline__ float bf2f(unsigned short b) { return __builtin_bit_cast(float, (unsigned)b << 16); }
__device__ __forceinline__ float bflo(unsigned w) { return __builtin_bit_cast(float, w << 16); }
__device__ __forceinline__ float bfhi(unsigned w) { return __builtin_bit_cast(float, w & 0xffff0000u); }
__device__ __forceinline__ unsigned pkh2(float lo, float hi) { const _Float16 a = (_Float16)lo, b = (_Float16)hi; return (unsigned)__builtin_bit_cast(unsigned short, a) | ((unsigned)__builtin_bit_cast(unsigned short, b) << 16); }
__device__ __forceinline__ float h2f(unsigned short b) { return (float)__builtin_bit_cast(_Float16, b); }
__device__ __forceinline__ float fast_sigmoid(float x) { return __builtin_amdgcn_rcpf(1.0f + __builtin_amdgcn_exp2f(-1.44269504089f * x)); }
__device__ __forceinline__ float fast_silu(float x) { return x * fast_sigmoid(x); }

#define XB_TMO      128
#define XB_XCNT(j)  (256  + 64 * (j))
#define XB_XSUB(j)  (1280 + 64 * (j))
#define XB_XGEN(j)  (2304 + 64 * (j))
#define XB_TOP      3328
#define XB_TOPGEN   3392
#define XCD_BAR_WORDS 3456
#define XB_SPIN_CAP (1u << 20)
__device__ __forceinline__ unsigned xb_ld(unsigned* p)              { return __hip_atomic_load(p, __ATOMIC_RELAXED, __HIP_MEMORY_SCOPE_AGENT); }
__device__ __forceinline__ unsigned xb_add(unsigned* p, unsigned v) { return __hip_atomic_fetch_add(p, v, __ATOMIC_RELAXED, __HIP_MEMORY_SCOPE_AGENT); }
__device__ __forceinline__ unsigned xb_xcc_id() { return (unsigned)__builtin_amdgcn_s_getreg((3 << 11) | 20) & 0xFu; }
#define XB_SPIN(cond, bar) do { unsigned _sp = 0; while (cond) { __builtin_amdgcn_s_sleep(1); \
    if ((++_sp & 255u) == 0u) { if (xb_ld(&(bar)[XB_TMO])) break; if (_sp > XB_SPIN_CAP) { atomicAdd(&(bar)[XB_TMO], 1u); break; } } } } while (0)
struct XcdBarrier { unsigned* bar; unsigned x; volatile LAS unsigned* st; };
__device__ __forceinline__ XcdBarrier xcd_barrier_post(unsigned* bar, volatile LAS unsigned* st) {
    XcdBarrier b; b.bar = bar; b.x = xb_xcc_id(); b.st = st;
    if (threadIdx.x == 0) (void)xb_add(&bar[XB_XCNT(b.x)], 1u);
    return b;
}
__device__ __forceinline__ void xcd_barrier_complete(unsigned* bar, unsigned x, unsigned& nloc, unsigned& nx) {
    const unsigned G = gridDim.x * gridDim.y * gridDim.z;
    unsigned sum, cnt, mine, sp = 0u;
    for (;;) {
        sum = 0u; cnt = 0u; mine = 0u;
#pragma unroll
        for (unsigned j = 0; j < 16; ++j) { const unsigned c = xb_ld(&bar[XB_XCNT(j)]); sum += c; cnt += (c > 0u) ? 1u : 0u; mine = (j == x) ? c : mine; }
        if (sum == G) break;
        __builtin_amdgcn_s_sleep(1);
        if ((++sp & 255u) == 0u) { if (xb_ld(&bar[XB_TMO])) break; if (sp > XB_SPIN_CAP) { atomicAdd(&bar[XB_TMO], 1u); break; } }
    }
    nloc = mine > 0u ? mine : 1u; nx = cnt > 0u ? cnt : 1u;
}
__device__ __forceinline__ void xcd_barrier(const XcdBarrier& b) {
    asm volatile("s_waitcnt vmcnt(0)" ::: "memory");
    __syncthreads();
    if (threadIdx.x == 0) {
        unsigned* bar = b.bar;
        __builtin_amdgcn_s_waitcnt(0);
        unsigned nloc = b.st[0], nx = b.st[1];
        if (nloc == 0u) { xcd_barrier_complete(bar, b.x, nloc, nx); b.st[0] = nloc; b.st[1] = nx; }
        const unsigned old = xb_add(&bar[XB_XSUB(b.x)], 1u);
        const unsigned gen = old / nloc;
        if (old + 1u == (gen + 1u) * nloc) {
            __builtin_amdgcn_fence(__ATOMIC_RELEASE, "agent");
            asm volatile("s_waitcnt vmcnt(0)" ::: "memory");
            const unsigned og = xb_add(&bar[XB_TOP], 1u);
            const unsigned tg = og / nx;
            if (og + 1u == (tg + 1u) * nx) xb_add(&bar[XB_TOPGEN], 1u);
            else XB_SPIN(xb_ld(&bar[XB_TOPGEN]) == tg, bar);
            __builtin_amdgcn_fence(__ATOMIC_ACQUIRE, "agent");
            xb_add(&bar[XB_XGEN(b.x)], 1u);
            asm volatile("s_waitcnt vmcnt(0)" ::: "memory");
        } else {
            XB_SPIN(xb_ld(&bar[XB_XGEN(b.x)]) == gen, bar);
            __builtin_amdgcn_fence(__ATOMIC_ACQUIRE, "agent");
            asm volatile("s_waitcnt vmcnt(0)" ::: "memory");
        }
    }
    __syncthreads();
}

using pg8::Unit; using pg8::cvt_pk_bf16; using pg8::HALF; using pg8::BM;
typedef float f4 __attribute__((ext_vector_type(4)));
typedef float f2v __attribute__((ext_vector_type(2)));

__device__ __forceinline__ void load_rs(const float* ss, int pm, int wr, int fr, float (&rsv)[2][4]) {
#pragma unroll
    for (int ai = 0; ai < 2; ++ai)
#pragma unroll
        for (int m = 0; m < 4; ++m) { const int row = pm * BM + ai * HALF + wr * 64 + m * 16 + fr; const f4 p = *(const f4*)(ss + (size_t)row * 4);
            rsv[ai][m] = 1.0f / sqrtf(((p.x + p.y) + (p.z + p.w)) * (1.0f / D) + EPS); }
}

struct EpiGU {
    static constexpr bool PERM = true, AFTER_DRAIN = false;
    bf16* act; const float* ss;
    __device__ __forceinline__ void operator()(const f4 (&acc)[2][2][4][2], const Unit& u, int wr, int wc, int fr, int fq) const {
        float rsv[2][4]; load_rs(ss, u.pm, wr, fr, rsv);
        const int col0 = u.pn * 128 + wc * 32 + 8 * fq;
#pragma unroll
        for (int ai = 0; ai < 2; ++ai)
#pragma unroll
            for (int m = 0; m < 4; ++m) { const int row = u.pm * BM + ai * HALF + wr * 64 + m * 16 + fr; const float rs = rsv[ai][m];
                float h[8];
#pragma unroll
                for (int n = 0; n < 2; ++n)
#pragma unroll
                    for (int j = 0; j < 4; ++j) { const float g = acc[ai][0][m][n][j] * rs, up = acc[ai][1][m][n][j] * rs; h[n * 4 + j] = fast_silu(g) * up; }
                v4u w; w.x = cvt_pk_bf16(h[0], h[1]); w.y = cvt_pk_bf16(h[2], h[3]); w.z = cvt_pk_bf16(h[4], h[5]); w.w = cvt_pk_bf16(h[6], h[7]);
                *(v4u*)(act + (size_t)row * FF + col0) = w; }
    }
};

struct EpiWin {
    static constexpr bool PERM = true, AFTER_DRAIN = false;
    unsigned char* ws; const float* ss;
    __device__ __forceinline__ void operator()(const f4 (&acc)[2][2][4][2], const Unit& u, int wr, int wc, int fr, int fq) const {
        float rsv[2][4]; load_rs(ss, u.pm, wr, fr, rsv);
        const int pn = u.pn;
        int mode, ld, colt; bf16* base;
        if (pn < 2) { mode = 0; base = (bf16*)(ws + WS_UPOOL); ld = 512; colt = pn * 256; }
        else if (pn < 4) { mode = 1; base = (bf16*)(ws + WS_Q); ld = 512; colt = (pn - 2) * 256; }
        else if (pn < 6) { mode = 2; base = (bf16*)(ws + WS_F); ld = 512; colt = (pn - 4) * 256; }
        else if (pn < 8) { mode = 0; base = (bf16*)(ws + WS_V); ld = 512; colt = (pn - 6) * 256; }
        else if (pn < 10) { mode = 1; base = (bf16*)(ws + WS_OG); ld = 512; colt = (pn - 8) * 256; }
        else { mode = 3; base = (bf16*)(ws + WS_GATES); ld = 2048; colt = (pn - 10) * 256; }
        const int col0 = colt + wc * 32 + 8 * fq;
#pragma unroll
        for (int ai = 0; ai < 2; ++ai)
#pragma unroll
            for (int m = 0; m < 4; ++m) { const int row = u.pm * BM + ai * HALF + wr * 64 + m * 16 + fr; const float rs = rsv[ai][m];
#pragma unroll
                for (int bj = 0; bj < 2; ++bj) {
                    float z[8];
#pragma unroll
                    for (int n = 0; n < 2; ++n)
#pragma unroll
                        for (int j = 0; j < 4; ++j) z[n * 4 + j] = acc[ai][bj][m][n][j] * rs;
                    v4u w;
                    if (mode == 2) { w.x = pkh2(z[0], z[1]); w.y = pkh2(z[2], z[3]); w.z = pkh2(z[4], z[5]); w.w = pkh2(z[6], z[7]); }
                    else {
                        if (mode == 1) {
#pragma unroll
                            for (int e = 0; e < 8; ++e) z[e] = fast_silu(z[e]);
                        } else if (mode == 3) {
#pragma unroll
                            for (int e = 0; e < 8; ++e) z[e] = fast_sigmoid(z[e]);
                        }
                        w.x = cvt_pk_bf16(z[0], z[1]); w.y = cvt_pk_bf16(z[2], z[3]); w.z = cvt_pk_bf16(z[4], z[5]); w.w = cvt_pk_bf16(z[6], z[7]);
                    }
                    *(v4u*)(base + (size_t)row * ld + col0 + bj * HALF) = w; } }
    }
};

struct EpiX {
    static constexpr bool PERM = true, AFTER_DRAIN = true;
    const float* xin; float* xout; bf16* xb; float* ss; float coef;
    __device__ __forceinline__ void fused(f4 (&acc)[2][2][4][2], const Unit& u, int wr, int wc, int fr, int fq, PG8_LAS unsigned char* lds, int wid, int lane) const {
        PG8_LAS float* P = (PG8_LAS float*)lds;
        const int col0 = u.pn * BM + wc * 32 + 8 * fq;
#pragma unroll
        for (int ai = 0; ai < 2; ++ai)
#pragma unroll
            for (int m = 0; m < 4; ++m) { const int rl = ai * HALF + wr * 64 + m * 16 + fr; const size_t off = (size_t)(u.pm * BM + rl) * D + col0;
                float s = 0.f;
#pragma unroll
                for (int bj = 0; bj < 2; ++bj) {
                    const f4 x0 = *(const f4*)(xin + off + bj * HALF), x1 = *(const f4*)(xin + off + bj * HALF + 4);
                    const f4 y0 = x0 + acc[ai][bj][m][0] * coef, y1 = x1 + acc[ai][bj][m][1] * coef;
                    *(f4*)(xout + off + bj * HALF) = y0; *(f4*)(xout + off + bj * HALF + 4) = y1;
                    v4u w; w.x = cvt_pk_bf16(y0[0], y0[1]); w.y = cvt_pk_bf16(y0[2], y0[3]); w.z = cvt_pk_bf16(y1[0], y1[1]); w.w = cvt_pk_bf16(y1[2], y1[3]);
                    *(v4u*)(xb + off + bj * HALF) = w;
                    s += (y0[0] * y0[0] + y0[1] * y0[1]) + (y0[2] * y0[2] + y0[3] * y0[3]) + (y1[0] * y1[0] + y1[1] * y1[1]) + (y1[2] * y1[2] + y1[3] * y1[3]); }
                s += __shfl_xor(s, 16); s += __shfl_xor(s, 32);
                if (fq == 0) P[rl * 4 + wc] = s; }
        asm volatile("s_waitcnt lgkmcnt(0)" ::: "memory"); __builtin_amdgcn_s_barrier(); asm volatile("" ::: "memory");
        const int t = wid * 64 + lane;
        if (t < 256) { const float a = P[t * 4 + 0], b = P[t * 4 + 1], c = P[t * 4 + 2], d = P[t * 4 + 3]; ss[(size_t)(u.pm * BM + t) * 4 + u.pn] = (a + b) + (c + d); }
        asm volatile("s_waitcnt lgkmcnt(0)" ::: "memory"); __builtin_amdgcn_s_barrier(); asm volatile("" ::: "memory");
    }
};

struct EpiProj {
    static constexpr bool PERM = true, AFTER_DRAIN = false;
    const bf16* gates; bf16* merged;
    __device__ __forceinline__ void operator()(const f4 (&acc)[2][2][4][2], const Unit& u, int wr, int wc, int fr, int fq) const {
        const int col0 = u.pn * BM + wc * 32 + 8 * fq;
#pragma unroll
        for (int ai = 0; ai < 2; ++ai)
#pragma unroll
            for (int m = 0; m < 4; ++m) { const int row = u.pm * BM + ai * HALF + wr * 64 + m * 16 + fr;
#pragma unroll
                for (int bj = 0; bj < 2; ++bj) {
                    const v4u g = *(const v4u*)(gates + (size_t)row * 2048 + (u.kind ? 1024 : 0) + col0 + bj * HALF);
                    bf16* mp = merged + (size_t)row * D + col0 + bj * HALF;
                    float y[8];
                    y[0] = bflo(g.x) * acc[ai][bj][m][0][0]; y[1] = bfhi(g.x) * acc[ai][bj][m][0][1]; y[2] = bflo(g.y) * acc[ai][bj][m][0][2]; y[3] = bfhi(g.y) * acc[ai][bj][m][0][3];
                    y[4] = bflo(g.z) * acc[ai][bj][m][1][0]; y[5] = bfhi(g.z) * acc[ai][bj][m][1][1]; y[6] = bflo(g.w) * acc[ai][bj][m][1][2]; y[7] = bfhi(g.w) * acc[ai][bj][m][1][3];
                    if (u.kind) { const v4u t = *(const v4u*)mp;
                        y[0] += bflo(t.x); y[1] += bfhi(t.x); y[2] += bflo(t.y); y[3] += bfhi(t.y); y[4] += bflo(t.z); y[5] += bfhi(t.z); y[6] += bflo(t.w); y[7] += bfhi(t.w); }
                    v4u w; w.x = cvt_pk_bf16(y[0], y[1]); w.y = cvt_pk_bf16(y[2], y[3]); w.z = cvt_pk_bf16(y[4], y[5]); w.w = cvt_pk_bf16(y[6], y[7]);
                    *(v4u*)mp = w; } }
    }
};

__device__ __forceinline__ float wave_sum(float v) {
#pragma unroll
    for (int o = 1; o < 64; o <<= 1) v += __shfl_xor(v, o);
    return v;
}
__device__ __forceinline__ void p0_transpose_item(const float* W, int K, int N, bf16* WT, const float* gain, int rowmode, LAS float* scr, int item, int lane) {
    const int nblk = N / 32, kb = item / nblk, nb = item % nblk, k0 = 64 * kb, n0 = 32 * nb;
#pragma unroll 8
    for (int i = 0; i < 32; ++i) { const int kk = 2 * i + (lane >> 5); float w = W[(size_t)(k0 + kk) * N + n0 + (lane & 31)]; if (gain) w *= gain[k0 + kk]; scr[kk * 33 + (lane & 31)] = w; }
    LDS_WAIT(); asm volatile("" ::: "memory");
    const int c = lane & 7;
#pragma unroll
    for (int j = 0; j < 4; ++j) { const int n = (lane >> 3) + 8 * j; const LAS float* s = scr + (8 * c) * 33 + n;
        v4u o; o.x = pk2(s[0 * 33], s[1 * 33]); o.y = pk2(s[2 * 33], s[3 * 33]); o.z = pk2(s[4 * 33], s[5 * 33]); o.w = pk2(s[6 * 33], s[7 * 33]);
        const int nn = n0 + n; const int orow = rowmode == 0 ? nn : (256 * (nn >> 7) + (nn & 127) + (rowmode == 2 ? 128 : 0));
        *(GAS v4u*)(WT + (size_t)orow * K + k0 + 8 * c) = o; }
    LDS_WAIT(); asm volatile("" ::: "memory");
}

struct Args { const float* in[19]; float* out; unsigned char* ws; int ph_lo, ph_hi; };

__device__ __forceinline__ void convert_weights(const Args& a, int l, LAS unsigned char* lds, int gw, int NGW, int wave, int lane) {
    LAS float* scr = (LAS float*)(lds + RING_OFF + wave * 16384);
    unsigned char* ws = a.ws;
    constexpr int I_GU = (D / 64) * (FF / 32), I_DN = (FF / 64) * (D / 32), I_IN = (D / 64) * (DIN / 32), I_PR = (PW / 64) * (D / 32), I_OUT = (D / 64) * (D / 32), I_PL = 4 * (128 / 64) * (128 / 32);
    constexpr int NITEMS = 4 * I_GU + 2 * I_DN + I_IN + 2 * I_PR + I_OUT + I_PL;
    for (int it = gw; it < NITEMS; it += NGW) {
        int r = it;
        if (r < I_GU) { p0_transpose_item(a.in[2] + (size_t)l * D * FF, D, FF, (bf16*)(ws + WS_WGU1), a.in[1] + l * D, 1, scr, r, lane); continue; } r -= I_GU;
        if (r < I_GU) { p0_transpose_item(a.in[3] + (size_t)l * D * FF, D, FF, (bf16*)(ws + WS_WGU1), a.in[1] + l * D, 2, scr, r, lane); continue; } r -= I_GU;
        if (r < I_GU) { p0_transpose_item(a.in[15] + (size_t)l * D * FF, D, FF, (bf16*)(ws + WS_WGU2), a.in[14] + l * D, 1, scr, r, lane); continue; } r -= I_GU;
        if (r < I_GU) { p0_transpose_item(a.in[16] + (size_t)l * D * FF, D, FF, (bf16*)(ws + WS_WGU2), a.in[14] + l * D, 2, scr, r, lane); continue; } r -= I_GU;
        if (r < I_DN) { p0_transpose_item(a.in[4] + (size_t)l * FF * D, FF, D, (bf16*)(ws + WS_WD1), nullptr, 0, scr, r, lane); continue; } r -= I_DN;
        if (r < I_DN) { p0_transpose_item(a.in[17] + (size_t)l * FF * D, FF, D, (bf16*)(ws + WS_WD2), nullptr, 0, scr, r, lane); continue; } r -= I_DN;
        if (r < I_IN) { p0_transpose_item(a.in[6] + (size_t)l * D * DIN, D, DIN, (bf16*)(ws + WS_WIN), a.in[5] + l * D, 0, scr, r, lane); continue; } r -= I_IN;
        if (r < I_PR) { p0_transpose_item(a.in[11] + (size_t)l * PW * D, PW, D, (bf16*)(ws + WS_WPA), nullptr, 0, scr, r, lane); continue; } r -= I_PR;
        if (r < I_PR) { p0_transpose_item(a.in[12] + (size_t)l * HG * D, HG, D, (bf16*)(ws + WS_WPB), nullptr, 0, scr, r, lane); continue; } r -= I_PR;
        if (r < I_OUT) { p0_transpose_item(a.in[13] + (size_t)l * D * D, D, D, (bf16*)(ws + WS_WOUT), nullptr, 0, scr, r, lane); continue; } r -= I_OUT;
        { const int g = r / 8, rr = r % 8; p0_transpose_item(a.in[7] + (size_t)(l * 4 + g) * 128 * 128, 128, 128, (bf16*)(ws + WS_POOLW) + (size_t)g * 128 * 128, nullptr, 0, scr, rr, lane); }
    }
}

__device__ __forceinline__ void x_to_bf16_ss(const float* x, bf16* xb, float* ss, int gw, int NGW, int lane) {
    for (int m = gw; m < M; m += NGW) {
        const GAS f32x4* xr = (const GAS f32x4*)(x + (size_t)m * D) + lane;
        f32x4 v[4]; float s = 0.f;
#pragma unroll
        for (int j = 0; j < 4; ++j) { v[j] = xr[64 * j]; s += (v[j].x * v[j].x + v[j].y * v[j].y) + (v[j].z * v[j].z + v[j].w * v[j].w); }
        s = wave_sum(s);
        GAS unsigned long long* o8 = (GAS unsigned long long*)(xb + (size_t)m * D) + lane;
#pragma unroll
        for (int j = 0; j < 4; ++j) o8[64 * j] = (unsigned long long)pk2(v[j].x, v[j].y) | ((unsigned long long)pk2(v[j].z, v[j].w) << 32);
        if (lane == 0) *(GAS f32x4*)(ss + (size_t)m * 4) = (f32x4){s, 0.f, 0.f, 0.f};
    }
}

__device__ __forceinline__ void final_norm(float* x, const float* g, int gw, int NGW, int lane) {
    f32x4 gv[4];
#pragma unroll
    for (int j = 0; j < 4; ++j) gv[j] = ((const GAS f32x4*)g)[lane + 64 * j];
    for (int m = gw; m < M; m += NGW) {
        GAS f32x4* xr = (GAS f32x4*)(x + (size_t)m * D) + lane;
        f32x4 v[4]; float s = 0.f;
#pragma unroll
        for (int j = 0; j < 4; ++j) { v[j] = xr[64 * j]; s += (v[j].x * v[j].x + v[j].y * v[j].y) + (v[j].z * v[j].z + v[j].w * v[j].w); }
        const float rs = 1.0f / sqrtf(wave_sum(s) * (1.0f / D) + EPS);
#pragma unroll
        for (int j = 0; j < 4; ++j) xr[64 * j] = v[j] * rs * gv[j];
    }
}

__device__ __forceinline__ float lb_of(const float* lb_logits, int l, int c) {
    if (l == 0) return 0.f;
    const float l0 = lb_logits[c], l1 = lb_logits[HG + c];
    return 1.0f / (1.0f + expf(l0 - l1));
}

typedef __bf16 bf16x2_t __attribute__((ext_vector_type(2)));
__device__ __forceinline__ unsigned pkc(float lo, float hi) { const bf16x2_t r = __builtin_convertvector((f2v){lo, hi}, bf16x2_t); return __builtin_bit_cast(unsigned, r); }
typedef short bf16x8 __attribute__((ext_vector_type(8)));
__device__ __forceinline__ f4 mfma16(bf16x8 x, bf16x8 y, f4 c) { return __builtin_amdgcn_mfma_f32_16x16x32_bf16(x, y, c, 0, 0, 0); }
__device__ __forceinline__ void wg_barrier() { asm volatile("s_waitcnt vmcnt(0) lgkmcnt(0)" ::: "memory"); __builtin_amdgcn_s_barrier(); asm volatile("" ::: "memory"); }

template <int W>
__device__ __forceinline__ void pool_window(const bf16* up  , int pos0, LAS unsigned short* Ds, int j, int ch) {
    float uu[31];
#pragma unroll
    for (int x = 0; x < 31; ++x) { uu[x] = 0.f; if (x >= 16 - W && pos0 - 15 + x >= 0) uu[x] = bf2f(up[(long)(x - 15) * PW]); }
#pragma unroll
    for (int i = 0; i < 16; ++i) { float sm = 0.f;
#pragma unroll
        for (int k = 0; k < W; ++k) sm += uu[15 + i - k];
        const int cnt = (pos0 + i + 1 < W) ? (pos0 + i + 1) : W;
        const float d = sm / (float)cnt - uu[15 + i];
        Ds[(16 * j + i) * 136 + ch] = (unsigned short)f2bf(d); }
}
__device__ __forceinline__ void pool_items(const bf16* upool, const bf16* poolwT, const float* pool_scale, bf16* pool_out, LAS unsigned char* lds, int vcu, int G, int tid_in) {
    LAS unsigned short* Ds = (LAS unsigned short*)lds;
    for (int it = vcu; it < (M / 64) * 4; it += G) {
        int tid = tid_in; asm volatile("" : "+v"(tid));
        const int lane = tid & 63, w = __builtin_amdgcn_readfirstlane(tid >> 6), fr = lane & 15, fq = lane >> 4, ch = tid & 127, j = tid >> 7;
        const int g = it & 3, row0 = (it >> 2) * 64, r0 = row0 + 16 * j, pos0 = r0 & (SEQ - 1);
        const bf16* up = upool + (size_t)r0 * PW + g * 128 + ch;
        if (g == 0) pool_window<2>(up, pos0, Ds, j, ch); else if (g == 1) pool_window<4>(up, pos0, Ds, j, ch); else if (g == 2) pool_window<8>(up, pos0, Ds, j, ch); else pool_window<16>(up, pos0, Ds, j, ch);
        wg_barrier();
        const int tt = w & 3, dh = w >> 2;
        bf16x8 yd[4];
#pragma unroll
        for (int ks = 0; ks < 4; ++ks) yd[ks] = *(const LAS bf16x8*)(Ds + (16 * tt + fr) * 136 + 32 * ks + 8 * fq);
#pragma unroll
        for (int dt = 0; dt < 4; ++dt) { const int dout0 = 16 * (4 * dh + dt); f4 acc = (f4){0.f, 0.f, 0.f, 0.f};
#pragma unroll
            for (int ks = 0; ks < 4; ++ks) { const bf16x8 xa = *(const bf16x8*)(poolwT + ((size_t)(g * 128 + dout0 + fr) * 128 + 32 * ks + 8 * fq)); acc = mfma16(xa, yd[ks], acc); }
            const f4 ps = *(const f4*)(pool_scale + g * 128 + dout0 + 4 * fq);
            v2u o; o.x = pkc(acc[0] * ps[0], acc[1] * ps[1]); o.y = pkc(acc[2] * ps[2], acc[3] * ps[3]);
            *(v2u*)(pool_out + (size_t)(row0 + 16 * tt + fr) * PW + g * 128 + dout0 + 4 * fq) = o; }
        wg_barrier();
    }
}

__device__ __forceinline__ void gate_fk(float z, float lb, float& f, float& k) {
    const float e = __expf(-fabsf(z)), r = __builtin_amdgcn_rcpf(1.0f + e), er = e * r;
    const float sg = z >= 0.f ? r : er, sm = z >= 0.f ? er : r;
    f = lb + (1.0f - lb) * sg; k = (1.0f - lb) * sm;
}
#define DPP_ROR_ADD(v, ctrl) v += __builtin_bit_cast(float, __builtin_amdgcn_update_dpp(0, __builtin_bit_cast(int, v), ctrl, 0xf, 0xf, false))
__device__ __forceinline__ float row16_allsum(float v) { DPP_ROR_ADD(v, 0x128); DPP_ROR_ADD(v, 0x124); DPP_ROR_ADD(v, 0x122); DPP_ROR_ADD(v, 0x121); return v; }
__device__ __forceinline__ v4u pack8(const float (&x)[8]) { v4u w; w.x = pkc(x[0], x[1]); w.y = pkc(x[2], x[3]); w.z = pkc(x[4], x[5]); w.w = pkc(x[6], x[7]); return w; }

__device__ __forceinline__ void hgrn_u_items(const bf16* F, const bf16* V, const float* lb_logits, int l, bf16* UT, float* DEC, LAS unsigned char* lds, int vcu, int G, int tid_in) {
    LAS unsigned short* vT = (LAS unsigned short*)lds; LAS unsigned short* keT = vT + 128 * 72; LAS float* TOT = (LAS float*)(lds + 2 * 128 * 72 * 2);
    for (int item = vcu; item < BATCH * NH * (SEQ / 64); item += G) {
        int tid = tid_in; asm volatile("" : "+v"(tid));
        const int lane = tid & 63, w = __builtin_amdgcn_readfirstlane(tid >> 6), fr = lane & 15, fq = lane >> 4, ch = tid & 127, j = tid >> 7;
        const int bh = item >> 7, n = item & 127, b = bh >> 2, h = bh & 3, hc = h * 128 + ch;
        const size_t row0 = (size_t)b * SEQ + n * 64 + 16 * j;
        const float lb = lb_of(lb_logits, l, hc);
        unsigned short fz[16], vv[16];
#pragma unroll
        for (int i = 0; i < 16; ++i) { fz[i] = F[(row0 + i) * HG + hc]; vv[i] = V[(row0 + i) * HG + hc]; }
        float ks[16]; float S = 1.0f;
#pragma unroll
        for (int i = 15; i >= 0; --i) { float f, k; gate_fk(h2f(fz[i]), lb, f, k); ks[i] = k * S; S *= f; }
        TOT[j * 128 + ch] = S;
        { v4u a, c; a.x = vv[0] | ((unsigned)vv[1] << 16); a.y = vv[2] | ((unsigned)vv[3] << 16); a.z = vv[4] | ((unsigned)vv[5] << 16); a.w = vv[6] | ((unsigned)vv[7] << 16);
          c.x = vv[8] | ((unsigned)vv[9] << 16); c.y = vv[10] | ((unsigned)vv[11] << 16); c.z = vv[12] | ((unsigned)vv[13] << 16); c.w = vv[14] | ((unsigned)vv[15] << 16);
          *(LAS v4u*)(vT + ch * 72 + 16 * j) = a; *(LAS v4u*)(vT + ch * 72 + 16 * j + 8) = c; }
        wg_barrier();
        { float sc = 1.0f;
#pragma unroll
          for (int m = 1; m < 4; ++m) if (m > j) sc *= TOT[m * 128 + ch];
          float x0[8], x1[8];
#pragma unroll
          for (int i = 0; i < 8; ++i) { x0[i] = ks[i] * sc; x1[i] = ks[8 + i] * sc; }
          *(LAS v4u*)(keT + ch * 72 + 16 * j) = pack8(x0); *(LAS v4u*)(keT + ch * 72 + 16 * j + 8) = pack8(x1);
          if (j == 0) DEC[(size_t)item * 128 + ch] = (TOT[ch] * TOT[128 + ch]) * (TOT[256 + ch] * TOT[384 + ch]); }
        wg_barrier();
        bf16x8 yb[2];
#pragma unroll
        for (int ksx = 0; ksx < 2; ++ksx) yb[ksx] = *(const LAS bf16x8*)(vT + (16 * w + fr) * 72 + 32 * ksx + 8 * fq);
        bf16* up = UT + ((size_t)item * 128 + 16 * w + fr) * 128 + 4 * fq;
#pragma unroll
        for (int dkt = 0; dkt < 8; ++dkt) { f4 acc = (f4){0.f, 0.f, 0.f, 0.f};
#pragma unroll
            for (int ksx = 0; ksx < 2; ++ksx) { const bf16x8 xa = *(const LAS bf16x8*)(keT + (16 * dkt + fr) * 72 + 32 * ksx + 8 * fq); acc = mfma16(xa, yb[ksx], acc); }
            v2u o; o.x = pkc(acc[0], acc[1]); o.y = pkc(acc[2], acc[3]);
            *(v2u*)(up + 16 * dkt) = o; }
        wg_barrier();
    }
}

__device__ __forceinline__ void hgrn_scan(bf16* UT, const float* DEC, int vcu, int tid) {
    if (tid >= 256) return;
    const int e = vcu * 256 + tid; if (e >= BATCH * NH * 128 * 64) return;
    const int dkp = e & 63, dv = (e >> 6) & 127, bh = e >> 13;
    unsigned* p = (unsigned*)(UT + ((size_t)bh * 128 * 128 + dv) * 128 + 2 * dkp);
    const f2v* dp = (const f2v*)(DEC + (size_t)bh * 128 * 128 + 2 * dkp);
    float s0 = 0.f, s1 = 0.f;
    for (int n0 = 0; n0 < 128; n0 += 8) {
        unsigned u[8]; f2v d[8];
#pragma unroll
        for (int i = 0; i < 8; ++i) { u[i] = p[(size_t)(n0 + i) * (128 * 128 / 2)]; d[i] = dp[(size_t)(n0 + i) * 64]; }
#pragma unroll
        for (int i = 0; i < 8; ++i) { p[(size_t)(n0 + i) * (128 * 128 / 2)] = pkc(s0, s1); s0 = d[i].x * s0 + bflo(u[i]); s1 = d[i].y * s1 + bfhi(u[i]); }
    }
}

constexpr int MC_QS = 0, MC_FS = MC_QS + 64 * 136 * 2, MC_KS = MC_FS + 64 * 132 * 4, MC_VT = MC_KS + 64 * 132 * 4, MC_TOT = MC_VT + 128 * 72 * 2, MC_AD = MC_TOT + 4 * 128 * 4, MC_PS = MC_AD + 4 * 16 * 20 * 4, MC_END = MC_PS + 2 * 64 * 4;
static_assert(MC_END <= RING_BYTES, "MIXC LDS");
__device__ __forceinline__ void hgrn_o_items(const bf16* Q, const bf16* F, const bf16* V, const bf16* OGs, const float* lb_logits, const float* hn, int l, const bf16* SPT, bf16* hout, LAS unsigned char* lds, int vcu, int G, int tid_in) {
    LAS unsigned short* Qs = (LAS unsigned short*)(lds + MC_QS); LAS float* Fs = (LAS float*)(lds + MC_FS); LAS float* Ks = (LAS float*)(lds + MC_KS);
    LAS unsigned short* vT = (LAS unsigned short*)(lds + MC_VT); LAS float* TOT = (LAS float*)(lds + MC_TOT); LAS float* AD = (LAS float*)(lds + MC_AD); LAS float* PS = (LAS float*)(lds + MC_PS);
    for (int item = vcu; item < BATCH * NH * (SEQ / 64); item += G) {
        int tid = tid_in; asm volatile("" : "+v"(tid));
        const int lane = tid & 63, w = __builtin_amdgcn_readfirstlane(tid >> 6), fr = lane & 15, fq = lane >> 4, ch = tid & 127, j = tid >> 7;
        const int wi = w & 3, h2 = w >> 2;
        const int bh = item >> 7, n = item & 127, b = bh >> 2, h = bh & 3, hc = h * 128 + ch;
        const size_t crow0 = (size_t)b * SEQ + n * 64;
        { const float lb = lb_of(lb_logits, l, hc); const size_t row0 = crow0 + 16 * j;
          unsigned short fz[16], vv[16], qq[16];
#pragma unroll
          for (int i = 0; i < 16; ++i) { fz[i] = F[(row0 + i) * HG + hc]; vv[i] = V[(row0 + i) * HG + hc]; qq[i] = Q[(row0 + i) * HG + hc]; }
#pragma unroll
          for (int i = 0; i < 16; ++i) { float f, k; gate_fk(h2f(fz[i]), lb, f, k); Fs[(16 * j + i) * 132 + ch] = f; Ks[(16 * j + i) * 132 + ch] = k; Qs[(16 * j + i) * 136 + ch] = qq[i]; }
          v4u a, c; a.x = vv[0] | ((unsigned)vv[1] << 16); a.y = vv[2] | ((unsigned)vv[3] << 16); a.z = vv[4] | ((unsigned)vv[5] << 16); a.w = vv[6] | ((unsigned)vv[7] << 16);
          c.x = vv[8] | ((unsigned)vv[9] << 16); c.y = vv[10] | ((unsigned)vv[11] << 16); c.z = vv[12] | ((unsigned)vv[13] << 16); c.w = vv[14] | ((unsigned)vv[15] << 16);
          *(LAS v4u*)(vT + ch * 72 + 16 * j) = a; *(LAS v4u*)(vT + ch * 72 + 16 * j + 8) = c; }
        wg_barrier();
        { const int sl = tid & 15, tp = (tid >> 4) & 7, i2 = tid >> 7, t1 = 15 - tp;
          float q0[8], q1[8], D0[8], D1[8];
          { const v4u a = *(const LAS v4u*)(Qs + (16 * i2 + tp) * 136 + 8 * sl), c = *(const LAS v4u*)(Qs + (16 * i2 + t1) * 136 + 8 * sl);
            q0[0] = bflo(a.x); q0[1] = bfhi(a.x); q0[2] = bflo(a.y); q0[3] = bfhi(a.y); q0[4] = bflo(a.z); q0[5] = bfhi(a.z); q0[6] = bflo(a.w); q0[7] = bfhi(a.w);
            q1[0] = bflo(c.x); q1[1] = bfhi(c.x); q1[2] = bflo(c.y); q1[3] = bfhi(c.y); q1[4] = bflo(c.z); q1[5] = bfhi(c.z); q1[6] = bflo(c.w); q1[7] = bfhi(c.w); }
#pragma unroll
          for (int e = 0; e < 8; ++e) { D0[e] = 1.0f; D1[e] = 1.0f; }
          LAS float* ad0 = AD + (i2 * 16 + tp) * 20; LAS float* ad1 = AD + (i2 * 16 + t1) * 20;
#pragma unroll 1
          for (int s = 15; s >= 8; --s) {
              const f4 k0 = *(const LAS f4*)(Ks + (16 * i2 + s) * 132 + 8 * sl), k1 = *(const LAS f4*)(Ks + (16 * i2 + s) * 132 + 8 * sl + 4);
              const f4 f0 = *(const LAS f4*)(Fs + (16 * i2 + s) * 132 + 8 * sl), f1 = *(const LAS f4*)(Fs + (16 * i2 + s) * 132 + 8 * sl + 4);
              const float kk[8] = {k0[0], k0[1], k0[2], k0[3], k1[0], k1[1], k1[2], k1[3]}, ff[8] = {f0[0], f0[1], f0[2], f0[3], f1[0], f1[1], f1[2], f1[3]};
              const bool on = s <= t1; float sm = 0.f;
#pragma unroll
              for (int e = 0; e < 8; ++e) { sm += q1[e] * kk[e] * D1[e]; D1[e] = on ? D1[e] * ff[e] : D1[e]; }
              sm = row16_allsum(on ? sm : 0.f);
              if (sl == 0) { ad1[s] = sm; ad0[s] = 0.f; }
          }
#pragma unroll 1
          for (int s = 7; s >= 0; --s) {
              const f4 k0 = *(const LAS f4*)(Ks + (16 * i2 + s) * 132 + 8 * sl), k1 = *(const LAS f4*)(Ks + (16 * i2 + s) * 132 + 8 * sl + 4);
              const f4 f0 = *(const LAS f4*)(Fs + (16 * i2 + s) * 132 + 8 * sl), f1 = *(const LAS f4*)(Fs + (16 * i2 + s) * 132 + 8 * sl + 4);
              const float kk[8] = {k0[0], k0[1], k0[2], k0[3], k1[0], k1[1], k1[2], k1[3]}, ff[8] = {f0[0], f0[1], f0[2], f0[3], f1[0], f1[1], f1[2], f1[3]};
              const bool on = s <= tp; float sm1 = 0.f, sm0 = 0.f;
#pragma unroll
              for (int e = 0; e < 8; ++e) { sm1 += q1[e] * kk[e] * D1[e]; D1[e] *= ff[e]; sm0 += q0[e] * kk[e] * D0[e]; D0[e] = on ? D0[e] * ff[e] : D0[e]; }
              sm1 = row16_allsum(sm1); sm0 = row16_allsum(on ? sm0 : 0.f);
              if (sl == 0) { ad1[s] = sm1; ad0[s] = sm0; }
          }
        }
        wg_barrier();
        bf16x8 spf[4][4];
#pragma unroll
        for (int d = 0; d < 4; ++d)
#pragma unroll
            for (int ksx = 0; ksx < 4; ++ksx) spf[d][ksx] = *(const bf16x8*)(SPT + ((size_t)item * 128 + 16 * (4 * h2 + d) + fr) * 128 + 32 * ksx + 8 * fq);
        { float fl[16];
#pragma unroll
          for (int i = 0; i < 16; ++i) fl[i] = Fs[(16 * j + i) * 132 + ch];
          float P = 1.0f;
#pragma unroll
          for (int i = 0; i < 16; ++i) { P *= fl[i]; const float qv = bf2f(Qs[(16 * j + i) * 136 + ch]); Qs[(16 * j + i) * 136 + ch] = (unsigned short)f2bf(qv * P); }
          float S = 1.0f;
#pragma unroll
          for (int i = 15; i >= 0; --i) { const float kv = Ks[(16 * j + i) * 132 + ch]; Ks[(16 * j + i) * 132 + ch] = kv * S; S *= fl[i]; }
          TOT[j * 128 + ch] = S; }
        wg_barrier();
        f4 acc[4];
#pragma unroll
        for (int d = 0; d < 4; ++d) acc[d] = (f4){0.f, 0.f, 0.f, 0.f};
        bf16x8 qr[4];
        f4 AT[3];
#pragma unroll
        for (int jj = 0; jj < 3; ++jj) AT[jj] = (f4){0.f, 0.f, 0.f, 0.f};
#pragma unroll
        for (int ksx = 0; ksx < 4; ++ksx) { const int dk0 = 32 * ksx + 8 * fq;
            const f4 ta0 = *(const LAS f4*)(TOT + dk0), ta1 = *(const LAS f4*)(TOT + dk0 + 4), tb0 = *(const LAS f4*)(TOT + 128 + dk0), tb1 = *(const LAS f4*)(TOT + 128 + dk0 + 4), tc0 = *(const LAS f4*)(TOT + 256 + dk0), tc1 = *(const LAS f4*)(TOT + 256 + dk0 + 4);
            const float T0[8] = {ta0[0], ta0[1], ta0[2], ta0[3], ta1[0], ta1[1], ta1[2], ta1[3]}, T1[8] = {tb0[0], tb0[1], tb0[2], tb0[3], tb1[0], tb1[1], tb1[2], tb1[3]}, T2[8] = {tc0[0], tc0[1], tc0[2], tc0[3], tc1[0], tc1[1], tc1[2], tc1[3]};
            const v4u qw = *(const LAS v4u*)(Qs + (16 * wi + fr) * 136 + dk0);
            qr[ksx] = __builtin_bit_cast(bf16x8, qw);
            float R[8], qf[8] = {bflo(qw.x), bfhi(qw.x), bflo(qw.y), bfhi(qw.y), bflo(qw.z), bfhi(qw.z), bflo(qw.w), bfhi(qw.w)};
#pragma unroll
            for (int e = 0; e < 8; ++e) { R[e] = (wi >= 1 ? T0[e] : 1.0f) * (wi >= 2 ? T1[e] : 1.0f) * (wi >= 3 ? T2[e] : 1.0f); qf[e] *= R[e]; }
            const bf16x8 qe = __builtin_bit_cast(bf16x8, pack8(qf));
#pragma unroll
            for (int d = 0; d < 4; ++d) acc[d] = mfma16(spf[d][ksx], qe, acc[d]);
#pragma unroll
            for (int jj = 0; jj < 3; ++jj) if (jj < wi) {
                const f4 c0 = *(const LAS f4*)(Ks + (16 * jj + fr) * 132 + dk0), c1 = *(const LAS f4*)(Ks + (16 * jj + fr) * 132 + dk0 + 4);
                float kr[8] = {c0[0], c0[1], c0[2], c0[3], c1[0], c1[1], c1[2], c1[3]};
#pragma unroll
                for (int e = 0; e < 8; ++e) { float sc = 1.0f; if (jj < 1 && wi > 1) sc *= T1[e]; if (jj < 2 && wi > 2) sc *= T2[e]; kr[e] *= sc; }
                AT[jj] = mfma16(__builtin_bit_cast(bf16x8, pack8(kr)), qr[ksx], AT[jj]); }
        }
        unsigned pk[4][2];
        { const f4 ad = *(const LAS f4*)(AD + (wi * 16 + fr) * 20 + 4 * fq);
#pragma unroll
          for (int jb = 0; jb < 4; ++jb) { f4 v = (f4){0.f, 0.f, 0.f, 0.f};
              if (jb < 3 && jb < wi) v = AT[jb < 3 ? jb : 0]; else if (jb == wi) v = ad;
              pk[jb][0] = pkc(v[0], v[1]); pk[jb][1] = pkc(v[2], v[3]); } }
#pragma unroll
        for (int kk = 0; kk < 2; ++kk) if (2 * kk <= wi) {
            v4u yv; yv.x = pk[2 * kk][0]; yv.y = pk[2 * kk][1]; yv.z = pk[2 * kk + 1][0]; yv.w = pk[2 * kk + 1][1];
            const bf16x8 y = __builtin_bit_cast(bf16x8, yv);
#pragma unroll
            for (int d = 0; d < 4; ++d) { const LAS unsigned short* vp = vT + (16 * (4 * h2 + d) + fr) * 72 + 32 * kk + 4 * fq;
                const v2u lo = *(const LAS v2u*)vp, hi = *(const LAS v2u*)(vp + 16);
                v4u xv; xv.x = lo.x; xv.y = lo.y; xv.z = hi.x; xv.w = hi.y;
                acc[d] = mfma16(__builtin_bit_cast(bf16x8, xv), y, acc[d]); } }
        { float ssq = 0.f;
#pragma unroll
          for (int d = 0; d < 4; ++d) ssq += (acc[d][0] * acc[d][0] + acc[d][1] * acc[d][1]) + (acc[d][2] * acc[d][2] + acc[d][3] * acc[d][3]);
          ssq += __shfl_xor(ssq, 16); ssq += __shfl_xor(ssq, 32);
          if (fq == 0) PS[h2 * 64 + 16 * wi + fr] = ssq; }
        wg_barrier();
        { const float tot = PS[16 * wi + fr] + PS[64 + 16 * wi + fr], rs = 1.0f / sqrtf(tot * (1.0f / HD) + EPS);
          const size_t row = crow0 + 16 * wi + fr;
#pragma unroll
          for (int d = 0; d < 4; ++d) { const int c0 = h * 128 + 16 * (4 * h2 + d) + 4 * fq;
              const f4 g = *(const f4*)(hn + c0); const v2u og = *(const v2u*)(OGs + row * HG + c0);
              v2u o; o.x = pkc(acc[d][0] * rs * g[0] * bflo(og.x), acc[d][1] * rs * g[1] * bfhi(og.x)); o.y = pkc(acc[d][2] * rs * g[2] * bflo(og.y), acc[d][3] * rs * g[3] * bfhi(og.y));
              *(v2u*)(hout + row * HG + c0) = o; } }
        wg_barrier();
    }
}

#ifndef HGRN_NAIVE
#define HGRN_NAIVE 0
#endif
#ifndef POOL_SKIP_MFMA
#define POOL_SKIP_MFMA 0
#endif
__device__ __forceinline__ void hgrn_naive(const bf16* Q, const bf16* F, const bf16* V, const float* lb_logits, int l, float* O, int gw, int NGW, int lane) {
    for (int item = gw; item < BATCH * NH * HD; item += NGW) {
        const int b = item >> 9, h = (item >> 7) & 3, dv = item & 127, c0 = h * 128 + 2 * lane;
        const float lb0 = lb_of(lb_logits, l, c0), lb1 = lb_of(lb_logits, l, c0 + 1);
        float S0 = 0.f, S1 = 0.f;
        for (int t0 = 0; t0 < SEQ; t0 += 8) {
            unsigned qw[8], fw[8]; unsigned short vw[8];
#pragma unroll
            for (int j = 0; j < 8; ++j) { const size_t row = (size_t)b * SEQ + t0 + j; qw[j] = *(const unsigned*)(Q + row * HG + c0); fw[j] = *(const unsigned*)(F + row * HG + c0); vw[j] = V[row * HG + h * 128 + dv]; }
            float p[8];
#pragma unroll
            for (int j = 0; j < 8; ++j) {
                const float z0 = h2f((unsigned short)(fw[j] & 0xffffu)), z1 = h2f((unsigned short)(fw[j] >> 16)), vv = bf2f(vw[j]);
                const float e0 = expf(-fabsf(z0)), r0 = 1.0f / (1.0f + e0), sg0 = z0 >= 0.f ? r0 : e0 * r0, sm0 = z0 >= 0.f ? e0 * r0 : r0;
                const float e1 = expf(-fabsf(z1)), r1 = 1.0f / (1.0f + e1), sg1 = z1 >= 0.f ? r1 : e1 * r1, sm1 = z1 >= 0.f ? e1 * r1 : r1;
                const float f0 = lb0 + (1.0f - lb0) * sg0, k0 = (1.0f - lb0) * sm0, f1 = lb1 + (1.0f - lb1) * sg1, k1 = (1.0f - lb1) * sm1;
                S0 = f0 * S0 + k0 * vv; S1 = f1 * S1 + k1 * vv;
                p[j] = bflo(qw[j]) * S0 + bfhi(qw[j]) * S1; }
#pragma unroll
            for (int j = 0; j < 8; ++j) p[j] = wave_sum(p[j]);
            if (lane == 0) {
#pragma unroll
                for (int j = 0; j < 8; ++j) O[((size_t)b * SEQ + t0 + j) * HG + h * 128 + dv] = p[j]; }
        }
    }
}

__device__ __forceinline__ void hgrn_norm_gate(const float* O, const bf16* OGs, const float* hn, bf16* hout, int gw, int NGW, int lane) {
    for (int item = gw; item < M * NH; item += NGW) {
        const int row = item >> 2, h = item & 3; const size_t off = (size_t)row * HG + h * 128 + 2 * lane;
        const f2v o = *(const f2v*)(O + off); const unsigned g = *(const unsigned*)(OGs + off);
        const float s = wave_sum(o.x * o.x + o.y * o.y), rs = 1.0f / sqrtf(s * (1.0f / HD) + EPS);
        const float y0 = o.x * rs * hn[h * 128 + 2 * lane] * bflo(g), y1 = o.y * rs * hn[h * 128 + 2 * lane + 1] * bfhi(g);
        *(unsigned*)(hout + off) = pk2(y0, y1);
    }
}

#ifndef HGRN_DEBUG
#define HGRN_DEBUG 0
#endif
constexpr int PH_PER_LAYER = 11 + HGRN_DEBUG, N_PHASES = 1 + DEPTH * PH_PER_LAYER + 1;
#if HGRN_DEBUG
enum { K_GU1 = 0, K_DOWN1, K_WIN, K_MIXA, K_SCAN, K_MIXC, K_DBG, K_PROJ, K_OUT, K_GU2, K_DOWN2, K_CONV };
#else
enum { K_GU1 = 0, K_DOWN1, K_WIN, K_MIXA, K_SCAN, K_MIXC, K_PROJ, K_OUT, K_GU2, K_DOWN2, K_CONV, K_DBG = 99 };
#endif

__global__ void __launch_bounds__(NWAVES * 64, 2) enc_fwd(Args args) {
    extern __shared__ __attribute__((aligned(16))) unsigned char lds_raw[];
    LAS unsigned char* lds = (LAS unsigned char*)lds_raw;
    volatile LAS unsigned* MISC = (volatile LAS unsigned*)(lds + MISC_OFF);
    const int G = gridDim.x, bx = blockIdx.x, vcu = (G % 8 == 0) ? (bx % 8) * (G / 8) + bx / 8 : bx;
    unsigned char* const ws = args.ws;
    { const int tid0 = threadIdx.x;
      for (int u = tid0; u < (LDS_BYTES - LDSCTL_OFF) / 4; u += NWAVES * 64) ((LAS unsigned*)(lds + LDSCTL_OFF))[u] = 0u; }
    __syncthreads();
    XcdBarrier bar; bar.bar = (unsigned*)(ws + WS_CTL) + CW_BAR; bar.x = 0; bar.st = nullptr;
#if !MK_PER_PHASE
    bar = xcd_barrier_post((unsigned*)(ws + WS_CTL) + CW_BAR, MISC + 8);
#endif
    const int lo = args.ph_lo, hi = args.ph_hi;
#define WSP(T, off) ((T*)(ws + (off)))
#pragma unroll 1
    for (int ph = lo; ph < hi; ++ph) {
        int tid = threadIdx.x; asm volatile("" : "+v"(tid));
        const int lane = tid & 63, wave = __builtin_amdgcn_readfirstlane(tid >> 6), gw = vcu * NWAVES + wave, NGW = G * NWAVES;
        const int l = (ph - 1) / PH_PER_LAYER, k = (ph - 1) % PH_PER_LAYER;
        if (ph == 0) {
            convert_weights(args, 0, lds, gw, NGW, wave, lane); x_to_bf16_ss(args.in[0], WSP(bf16, WS_XB), WSP(float, WS_SS), gw, NGW, lane);
        } else if (ph == N_PHASES - 1) {
            final_norm(args.out, args.in[18], gw, NGW, lane);
        } else if (k == K_GU1 || k == K_GU2) {
            pg8::StaticOrder S; S.init(WSP(bf16, WS_XB), ws + (k == K_GU1 ? WS_WGU1 : WS_WGU2), M, 2 * FF, D, G, bx); EpiGU E{WSP(bf16, WS_ACT), WSP(float, WS_SS)};
            pg8::gemm_phase<EpiGU, pg8::StaticOrder, true, true>(lds + RING_OFF, D, S, E);
        } else if (k == K_DOWN1 || k == K_DOWN2 || k == K_OUT) {
            const bool isout = (k == K_OUT); const int KK = isout ? D : FF;
            pg8::StaticOrder S; S.init(isout ? WSP(bf16, WS_MERGED) : WSP(bf16, WS_ACT), ws + (isout ? WS_WOUT : (k == K_DOWN1 ? WS_WD1 : WS_WD2)), M, D, KK, G, bx);
            EpiX E{(l == 0 && k == K_DOWN1) ? args.in[0] : args.out, args.out, WSP(bf16, WS_XB), WSP(float, WS_SS), isout ? 1.0f : 0.5f};
            pg8::gemm_phase<EpiX, pg8::StaticOrder, false, true>(lds + RING_OFF, KK, S, E);
        } else if (k == K_WIN) {
            pg8::StaticOrder S; S.init(WSP(bf16, WS_XB), ws + WS_WIN, M, DIN, D, G, bx); EpiWin E{ws, WSP(float, WS_SS)};
            pg8::gemm_phase<EpiWin, pg8::StaticOrder, true, true>(lds + RING_OFF, D, S, E);
        } else if (k == K_MIXA) {
            pool_items(WSP(bf16, WS_UPOOL), WSP(bf16, WS_POOLW), args.in[8] + l * PW, WSP(bf16, WS_POOLOUT), lds + RING_OFF, vcu, G, tid);
#if HGRN_NAIVE
            hgrn_naive(WSP(bf16, WS_Q), WSP(bf16, WS_F), WSP(bf16, WS_V), args.in[9], l, WSP(float, WS_XB), gw, NGW, lane);
#else
            hgrn_u_items(WSP(bf16, WS_F), WSP(bf16, WS_V), args.in[9], l, WSP(bf16, WS_XB), WSP(float, WS_DEC), lds + RING_OFF, vcu, G, tid);
#endif
        } else if (k == K_SCAN) {
#if !HGRN_NAIVE
            hgrn_scan(WSP(bf16, WS_XB), WSP(float, WS_DEC), vcu, tid);
#endif
        } else if (k == K_MIXC) {
#if HGRN_DEBUG
            hgrn_naive(WSP(bf16, WS_Q), WSP(bf16, WS_F), WSP(bf16, WS_V), args.in[9], l, WSP(float, WS_XB), gw, NGW, lane);
#elif HGRN_NAIVE
            hgrn_norm_gate(WSP(float, WS_XB), WSP(bf16, WS_OG), args.in[10] + l * HG, WSP(bf16, WS_HOUT), gw, NGW, lane);
#else
            hgrn_o_items(WSP(bf16, WS_Q), WSP(bf16, WS_F), WSP(bf16, WS_V), WSP(bf16, WS_OG), args.in[9], args.in[10] + l * HG, l, WSP(bf16, WS_XB), WSP(bf16, WS_HOUT), lds + RING_OFF, vcu, G, tid);
#endif
        } else if (k == K_DBG) {
            hgrn_norm_gate(WSP(float, WS_XB), WSP(bf16, WS_OG), args.in[10] + l * HG, WSP(bf16, WS_HOUT), gw, NGW, lane);
        } else if (k == K_PROJ) {
            pg8::PairOrder S; S.init(WSP(bf16, WS_POOLOUT), ws + WS_WPA, WSP(bf16, WS_HOUT), ws + WS_WPB, M, D, PW, G, bx); EpiProj E{WSP(bf16, WS_GATES), WSP(bf16, WS_MERGED)};
            pg8::gemm_phase<EpiProj, pg8::PairOrder, true, true>(lds + RING_OFF, PW, S, E);
        } else {
            if (l + 1 >= DEPTH) continue;
            __syncthreads(); convert_weights(args, l + 1, lds, gw, NGW, wave, lane);
        }
#if !MK_PER_PHASE
        if (ph + 1 < hi) xcd_barrier(bar);
#endif
    }
#undef WSP
}

extern "C" void kernel_launch(void* const* d_in, const int* in_sizes, int n_in, void* d_out, int out_size, void* d_ws, size_t ws_size, hipStream_t stream) {
    static int grid = 0;
    if (grid == 0) {
        if (n_in != 19 || in_sizes[0] != M * D || out_size != M * D || ws_size < WS_END) { fprintf(stderr, "kernel_launch: unexpected shapes (n_in %d, in0 %d, out %d, ws %zu); nothing launched\n", n_in, n_in > 0 ? in_sizes[0] : -1, out_size, ws_size); grid = -1; return; }
        int dev = 0, cus = 0, per_cu = 0;
        if (hipGetDevice(&dev) != hipSuccess || hipDeviceGetAttribute(&cus, hipDeviceAttributeMultiprocessorCount, dev) != hipSuccess) { grid = -1; return; }
        if (hipFuncSetAttribute((const void*)enc_fwd, hipFuncAttributeMaxDynamicSharedMemorySize, LDS_BYTES) != hipSuccess) { fprintf(stderr, "kernel_launch: hipFuncSetAttribute failed\n"); grid = -1; return; }
        if (hipOccupancyMaxActiveBlocksPerMultiprocessor(&per_cu, (const void*)enc_fwd, NWAVES * 64, LDS_BYTES) != hipSuccess || per_cu < 1)
            fprintf(stderr, "kernel_launch: note: occupancy query reports %d workgroups per CU\n", per_cu);
        (void)hipGetLastError();
        grid = cus;
        if (grid != 256) fprintf(stderr, "kernel_launch: %d CUs; this kernel is laid out for 256\n", grid);
    }
    if (grid < 0) return;
    (void)hipMemsetAsync((char*)d_ws + WS_CTL, 0, CTL_ZERO_BYTES, stream);
    Args a{};
    for (int i = 0; i < 19; ++i) a.in[i] = (const float*)d_in[i];
    a.out = (float*)d_out; a.ws = (unsigned char*)d_ws;
#if MK_PER_PHASE
    for (int p = 0; p < N_PHASES; ++p) { a.ph_lo = p; a.ph_hi = p + 1; hipLaunchKernelGGL(enc_fwd, dim3(grid), dim3(NWAVES * 64), LDS_BYTES, stream, a); }
#else
    a.ph_lo = 0; a.ph_hi = N_PHASES;
    hipLaunchKernelGGL(enc_fwd, dim3(grid), dim3(NWAVES * 64), LDS_BYTES, stream, a);
#endif
}
```

```cpp
#include <hip/hip_runtime.h>
#include <cstdio>
#include <cstdint>

#ifndef STAG_DL
#define STAG_DL 0
#define STAG_DS 0
#endif
#ifndef SKIP_STORE_WAIT
#define SKIP_STORE_WAIT 1
#endif
#ifndef DBL_MASK
#define DBL_MASK 0
#endif

namespace pg8 {
#define PG8_LAS __attribute__((address_space(3)))
typedef unsigned short bf16_t;
typedef short bf16x8 __attribute__((ext_vector_type(8)));
typedef float f32x4 __attribute__((ext_vector_type(4)));
typedef unsigned u32x4 __attribute__((ext_vector_type(4)));
typedef unsigned u32x2 __attribute__((ext_vector_type(2)));
constexpr int BM = 256, BK = 64, HALF = 128, HTB = HALF * BK * 2  , STAGE_BYTES = 8 * HTB, NXCD = 8, WGM = 8;

__host__ __device__ __forceinline__ int lds_byte(int r, int c) { const int st = (r >> 4) * 2 + (c >> 5), rr = r & 15, cc = c & 31, ob = rr * 64 + cc * 2; return st * 1024 + (ob ^ (((ob >> 9) & 1) << 5)); }
__host__ __device__ __forceinline__ void stage_rc(int b, int& R, int& C) { const int st = b / 1024, sb = b % 1024, swz = sb ^ (((sb >> 9) & 1) << 5); R = (st >> 1) * 16 + swz / 64; C = (st & 1) * 32 + (swz % 64) / 2; }
__host__ __device__ __forceinline__ int perm32(int rho) { const int n = rho >> 4, i = rho & 15; return 8 * (i >> 2) + 4 * n + (i & 3); }

struct Unit { int pm, pn, kind; const char* A; const char* B; };

struct TileOrder {
    int nM, nN, nwg, G, c;
    __host__ __device__ void init(int M, int N, int G_, int c_) { nM = M / BM; nN = N / BM; nwg = nM * nN; G = G_; c = c_; }
    __host__ __device__ bool tile(int i, int& pm, int& pn) const {
        const long L = (long)i * G + c; if (L >= nwg) return false;
        int wgid = (int)L; { const int q = nwg / NXCD, r = nwg % NXCD, xcd = wgid % NXCD, off = wgid / NXCD; wgid = (xcd < r ? xcd * (q + 1) : r * (q + 1) + (xcd - r) * q) + off; }
        const int nig = WGM * nN, gid = wgid / nig, fm = gid * WGM, gsz = (nM - fm) < WGM ? (nM - fm) : WGM;
        pm = fm + ((wgid % nig) % gsz); pn = (wgid % nig) / gsz; return true;
    }
};
__device__ __forceinline__ int stagger_ticks(const TileOrder& T, int DL, int DS) {
    const int rem = T.nwg % T.G; if (rem == 0) return 0;
    return T.c < rem ? (T.c * DL) / rem : DL + ((T.c - rem) * DS) / (T.G - rem);
}
struct StaticOrder {
    TileOrder T; const char* A; const char* Bt; size_t tstep;
    __device__ void init(const void* A_, const void* Bt_, int M, int N, int K, int G, int c) { T.init(M, N, G, c); A = (const char*)A_; Bt = (const char*)Bt_; tstep = (size_t)BM * K * 2; }
    __device__ __forceinline__ bool next(int i, Unit& u) const { if (!T.tile(i, u.pm, u.pn)) return false; u.kind = 0; u.A = A + (size_t)u.pm * tstep; u.B = Bt + (size_t)u.pn * tstep; return true; }
};
struct PairOrder {
    TileOrder T; const char *A0, *B0, *A1, *B1; size_t tstep;
    __device__ void init(const void* A0_, const void* B0_, const void* A1_, const void* B1_, int M, int N, int K, int G, int c) { T.init(M, N, G, c); A0 = (const char*)A0_; B0 = (const char*)B0_; A1 = (const char*)A1_; B1 = (const char*)B1_; tstep = (size_t)BM * K * 2; }
    __device__ __forceinline__ bool next(int i, Unit& u) const { if (i >= 2) return false; if (!T.tile(0, u.pm, u.pn)) return false; u.kind = i;
        u.A = (i == 0 ? A0 : A1) + (size_t)u.pm * tstep; u.B = (i == 0 ? B0 : B1) + (size_t)u.pn * tstep; return true; }
};

__device__ __forceinline__ unsigned cvt_pk_bf16(float lo, float hi) { unsigned r; asm volatile("v_cvt_pk_bf16_f32 %0, %1, %2" : "=v"(r) : "v"(lo), "v"(hi)); return r; }

template <class Epi, class Sched, bool ALIGN_EPI = false, bool SP2 = false>
__device__ __forceinline__ void gemm_phase(PG8_LAS unsigned char* lds, const int K, const Sched& S, const Epi& E, const int tid_in, const int delay = 0) {
    int tid_ = tid_in; asm volatile("" : "+v"(tid_));
    const int tid = tid_, wid = __builtin_amdgcn_readfirstlane(tid >> 6), lane = tid & 63, wr = wid >> 2, wc = wid & 3, fr = lane & 15, fq = lane >> 4;
    const int nt = K / BK;
    unsigned voffA[2], voffB[2];
#pragma unroll
    for (int i = 0; i < 2; ++i) { int R, C; stage_rc(tid * 16 + i * 8192, R, C); const int Rb = Epi::PERM ? ((R & ~31) + perm32(R & 31)) : R;
        voffA[i] = (unsigned)(R * K + C) * 2u; voffB[i] = (unsigned)(Rb * K + C) * 2u; }
    const size_t kstep = (size_t)(BK * 2);
    const size_t hstep = (size_t)HALF * K * 2;
    const unsigned ldsw = (unsigned)wid * 1024u;
    const int aoff = lds_byte(wr * 64 + fr, fq * 8), boff = lds_byte(wc * 32 + fr, fq * 8);
#define PG8_SA(b, h) (((b) * 2 + (h)) * HTB)
#define PG8_SB(b, h) ((4 + (b) * 2 + (h)) * HTB)
#define PG8_STAGE(bufoff, gbase, voff) do { _Pragma("unroll") for (int _i = 0; _i < 2; ++_i) \
        __builtin_amdgcn_global_load_lds((const unsigned*)((const char*)(gbase) + (voff)[_i]), (PG8_LAS unsigned*)(lds + (bufoff) + ldsw + _i * 8192), 16, 0, 0); } while (0)
#define PG8_LDA(dst, b, h) do { _Pragma("unroll") for (int m = 0; m < 4; ++m) _Pragma("unroll") for (int k = 0; k < 2; ++k) dst[m][k] = *(const PG8_LAS bf16x8*)(lds + PG8_SA(b, h) + aoff + m * 2048 + k * 1024); } while (0)
#define PG8_LDB(dst, b, h) do { _Pragma("unroll") for (int n = 0; n < 2; ++n) _Pragma("unroll") for (int k = 0; k < 2; ++k) dst[n][k] = *(const PG8_LAS bf16x8*)(lds + PG8_SB(b, h) + boff + n * 2048 + k * 1024); } while (0)
#define PG8_MMA(ai, bj, At, Bt) do { __builtin_amdgcn_s_setprio(1); _Pragma("unroll") for (int m = 0; m < 4; ++m) _Pragma("unroll") for (int n = 0; n < 2; ++n) _Pragma("unroll") for (int k = 0; k < 2; ++k) \
        acc[ai][bj][m][n] = __builtin_amdgcn_mfma_f32_16x16x32_bf16(Bt[n][k], At[m][k], acc[ai][bj][m][n], 0, 0, 0); __builtin_amdgcn_s_setprio(0); } while (0)
#define PG8_WAIT_V(n) asm volatile("s_waitcnt vmcnt(" #n ")" ::: "memory")
#define PG8_WAIT_L(n) asm volatile("s_waitcnt lgkmcnt(" #n ")" ::: "memory")
#define PG8_BAR __builtin_amdgcn_s_barrier()
#define PG8_SCHED __builtin_amdgcn_sched_barrier(0)
    Unit cur, nxt; int ui = 0;
    if (!S.next(0, cur)) return;
    if (delay > 0) {
        const unsigned long long t0 = __builtin_amdgcn_s_memrealtime();
        while ((long long)(__builtin_amdgcn_s_memrealtime() - t0) < (long long)delay) __builtin_amdgcn_s_sleep(8);
    }
    f32x4 acc[2][2][4][2];
#pragma unroll
    for (int a = 0; a < 2; ++a)
#pragma unroll
        for (int b = 0; b < 2; ++b)
#pragma unroll
            for (int m = 0; m < 4; ++m)
#pragma unroll
                for (int n = 0; n < 2; ++n) acc[a][b][m][n] = (f32x4){0.f, 0.f, 0.f, 0.f};
    bf16x8 At[4][2], B0[2][2], B1[2][2];
    const char* cA = cur.A; const char* cB = cur.B;
    if constexpr (SP2) {
        PG8_STAGE(PG8_SB(0, 0), cB, voffB); PG8_STAGE(PG8_SB(0, 1), cB + hstep, voffB); PG8_STAGE(PG8_SA(0, 0), cA, voffA); PG8_STAGE(PG8_SA(0, 1), cA + hstep, voffA);
        if (wr == 1) PG8_BAR;
        PG8_WAIT_V(2); PG8_BAR;
        PG8_STAGE(PG8_SB(1, 0), cB + kstep, voffB); PG8_STAGE(PG8_SA(1, 0), cA + kstep, voffA); PG8_STAGE(PG8_SB(1, 1), cB + hstep + kstep, voffB);
        PG8_WAIT_V(6); PG8_BAR;
    } else {
        PG8_STAGE(PG8_SB(0, 0), cB, voffB); PG8_STAGE(PG8_SA(0, 0), cA, voffA); PG8_STAGE(PG8_SB(0, 1), cB + hstep, voffB); PG8_STAGE(PG8_SA(0, 1), cA + hstep, voffA);
        if (wr == 1) PG8_BAR;
        PG8_WAIT_V(4); PG8_BAR;
        PG8_STAGE(PG8_SB(1, 0), cB + kstep, voffB); PG8_STAGE(PG8_SA(1, 0), cA + kstep, voffA); PG8_STAGE(PG8_SB(1, 1), cB + hstep + kstep, voffB);
        PG8_WAIT_V(6); PG8_BAR;
    }
    for (;;) {
        const bool has_next = S.next(ui + 1, nxt);
        const char* nA = has_next ? nxt.A : cA; const char* nB = has_next ? nxt.B : cB;
        static_assert(SP2, "this build keeps only the two-super-phase K-loop");
        for (int t = 0; t < nt; t += 2) {
            const bool last = (t == nt - 2);
            const int keepw = __builtin_amdgcn_readfirstlane((SKIP_STORE_WAIT && Epi::DRAINS && t == 0 && ui > 0) ? 0 : 1);
#define PG8_WAIT_V8_IF(c) do { if constexpr (SKIP_STORE_WAIT && Epi::DRAINS) asm volatile("s_cmp_eq_u32 %0, 0\n\ts_cbranch_scc1 .Lpg8skip%=\n\ts_waitcnt vmcnt(8)\n.Lpg8skip%=:" :: "s"(c) : "scc", "memory"); \
                                 else PG8_WAIT_V(8); } while (0)
            const char* a1 = cA + (size_t)(t + 1) * kstep;
            const char* a2 = last ? nA : cA + (size_t)(t + 2) * kstep; const char* b2 = last ? nB : cB + (size_t)(t + 2) * kstep;
            const char* a3 = a2 + kstep; const char* b3 = b2 + kstep;
            PG8_LDB(B0, 0, 0); PG8_LDB(B1, 0, 1); PG8_SCHED; PG8_LDA(At, 0, 0); PG8_STAGE(PG8_SA(1, 1), a1 + hstep, voffA);
            PG8_WAIT_V8_IF(keepw); PG8_WAIT_L(0); PG8_BAR; PG8_MMA(0, 0, At, B0); PG8_MMA(0, 1, At, B1); PG8_BAR; PG8_SCHED;
            PG8_LDA(At, 0, 1); PG8_STAGE(PG8_SB(0, 0), b2, voffB); PG8_STAGE(PG8_SB(0, 1), b2 + hstep, voffB); PG8_STAGE(PG8_SA(0, 0), a2, voffA);
            PG8_WAIT_V8_IF(keepw); PG8_WAIT_L(0); PG8_BAR; PG8_MMA(1, 0, At, B0); PG8_MMA(1, 1, At, B1); PG8_BAR; PG8_SCHED;
            PG8_LDB(B0, 1, 0); PG8_LDB(B1, 1, 1); PG8_SCHED; PG8_LDA(At, 1, 0); PG8_STAGE(PG8_SA(0, 1), a2 + hstep, voffA);
            PG8_WAIT_V(8); PG8_WAIT_L(0); PG8_BAR; PG8_MMA(0, 0, At, B0); PG8_MMA(0, 1, At, B1); PG8_BAR; PG8_SCHED;
            PG8_LDA(At, 1, 1); PG8_STAGE(PG8_SB(1, 0), b3, voffB); PG8_STAGE(PG8_SB(1, 1), b3 + hstep, voffB); PG8_STAGE(PG8_SA(1, 0), a3, voffA);
            PG8_WAIT_V(8); PG8_WAIT_L(0); PG8_BAR; PG8_MMA(1, 0, At, B0); PG8_MMA(1, 1, At, B1); PG8_BAR; PG8_SCHED;
#undef PG8_WAIT_V8_IF
        }
        if constexpr (ALIGN_EPI) { if (wr == 0) PG8_BAR; }
        if constexpr (!Epi::AFTER_DRAIN) { E(acc, cur, wr, wc, fr, fq); }
        if (!has_next) break;
#pragma unroll
        for (int a = 0; a < 2; ++a)
#pragma unroll
            for (int b = 0; b < 2; ++b)
#pragma unroll
                for (int m = 0; m < 4; ++m)
#pragma unroll
                    for (int n = 0; n < 2; ++n) acc[a][b][m][n] = (f32x4){0.f, 0.f, 0.f, 0.f};
        cur = nxt; cA = nA; cB = nB; ++ui;
        if constexpr (ALIGN_EPI) { if (wr == 1) PG8_BAR; }
    }
    PG8_WAIT_V(0);
    if constexpr (!ALIGN_EPI) { if (wr == 0) PG8_BAR; }
    PG8_BAR;
    if constexpr (Epi::AFTER_DRAIN) { E.fused(acc, cur, wr, wc, fr, fq, lds, wid, lane); }
#undef PG8_SA
#undef PG8_SB
#undef PG8_STAGE
#undef PG8_LDA
#undef PG8_LDB
#undef PG8_MMA
#undef PG8_WAIT_V
#undef PG8_WAIT_L
#undef PG8_BAR
#undef PG8_SCHED
}
}

constexpr int NWAVES = 8;
constexpr int BATCH = 2, SEQ = 8192, D = 1024, DEPTH = 2, FF = 2816, DIN = 4608, PW = 512, HG = 512, NH = 4, HD = 128;
constexpr int M = BATCH * SEQ;
constexpr float EPS = 1e-6f;

constexpr size_t MiB = 1u << 20;
constexpr size_t WS_CTL = 0, CTL_ZERO_BYTES = 1 * MiB;
constexpr size_t WS_SS = 1 * MiB;
constexpr size_t WS_DEC = WS_SS + 512 * 1024;
constexpr size_t WS_WGU1 = 2 * MiB;
constexpr size_t WS_WD1 = WS_WGU1 + 11 * MiB;
constexpr size_t WS_WIN = WS_WD1 + 11 * MiB / 2;
constexpr size_t WS_WPA = WS_WIN + 9 * MiB;
constexpr size_t WS_WPB = WS_WPA + 1 * MiB;
constexpr size_t WS_WOUT = WS_WPB + 1 * MiB;
constexpr size_t WS_WGU2 = WS_WOUT + 2 * MiB;
constexpr size_t WS_WD2 = WS_WGU2 + 11 * MiB;
constexpr size_t WS_POOLW = WS_WD2 + 11 * MiB / 2;
constexpr size_t WS_XB = 49 * MiB;
constexpr size_t WS_ACT = 81 * MiB;
constexpr size_t WS_UPOOL = 81 * MiB, WS_Q = 97 * MiB, WS_F = 113 * MiB, WS_V = 129 * MiB, WS_OG = 145 * MiB, WS_GATES = 161 * MiB, WS_POOLOUT = 225 * MiB;
constexpr size_t WS_HOUT = WS_UPOOL;
constexpr size_t WS_MERGED = WS_Q;
constexpr size_t WS_END = 241 * MiB;
static_assert(WS_POOLW + 4 * 128 * 128 * 2 <= WS_XB, "weights region");
static_assert(WS_ACT + (size_t)M * FF * 2 <= 256 * MiB, "act region");

constexpr int CW_BAR = 4096;
constexpr int LDS_BYTES = 147456;
constexpr int RING_OFF = 0, RING_BYTES = 131072, LDSCTL_OFF = RING_BYTES, MISC_OFF = LDSCTL_OFF + 320;

#define GAS __attribute__((address_space(1)))
#define LAS __attribute__((address_space(3)))
typedef unsigned short bf16;
typedef unsigned v4u __attribute__((ext_vector_type(4)));
typedef unsigned v2u __attribute__((ext_vector_type(2)));
typedef float f32x4 __attribute__((ext_vector_type(4)));
typedef GAS unsigned gu32;
#define RLX_AGENT __ATOMIC_RELAXED, __HIP_MEMORY_SCOPE_AGENT
#define LDS_WAIT() asm volatile("s_waitcnt lgkmcnt(0)" ::: "memory")
#define VM_WAIT() asm volatile("s_waitcnt vmcnt(0)" ::: "memory")
__device__ __forceinline__ unsigned f2bf(float f) { unsigned u = __builtin_bit_cast(unsigned, f); return (u + 0x7fffu + ((u >> 16) & 1u)) >> 16; }
__device__ __forceinline__ unsigned pk2(float lo, float hi) { return f2bf(lo) | (f2bf(hi) << 16); }
__device__ __forceinline__ float bf2f(unsigned short b) { return __builtin_bit_cast(float, (unsigned)b << 16); }
__device__ __forceinline__ float bflo(unsigned w) { return __builtin_bit_cast(float, w << 16); }
__device__ __forceinline__ float bfhi(unsigned w) { return __builtin_bit_cast(float, w & 0xffff0000u); }
__device__ __forceinline__ unsigned pkh2(float lo, float hi) { const _Float16 a = (_Float16)lo, b = (_Float16)hi; return (unsigned)__builtin_bit_cast(unsigned short, a) | ((unsigned)__builtin_bit_cast(unsigned short, b) << 16); }
__device__ __forceinline__ float h2f(unsigned short b) { return (float)__builtin_bit_cast(_Float16, b); }
__device__ __forceinline__ float fast_sigmoid(float x) { return __builtin_amdgcn_rcpf(1.0f + __builtin_amdgcn_exp2f(-1.44269504089f * x)); }
__device__ __forceinline__ float fast_silu(float x) { return x * fast_sigmoid(x); }

#define XB_TMO      128
#define XB_XCNT(j)  (256  + 64 * (j))
#define XB_XSUB(j)  (1280 + 64 * (j))
#define XB_XGEN(j)  (2304 + 64 * (j))
#define XB_TOP      3328
#define XB_TOPGEN   3392
#define XCD_BAR_WORDS 3456
#define XB_SPIN_CAP (1u << 20)
__device__ __forceinline__ unsigned xb_ld(unsigned* p)              { return __hip_atomic_load(p, __ATOMIC_RELAXED, __HIP_MEMORY_SCOPE_AGENT); }
__device__ __forceinline__ unsigned xb_add(unsigned* p, unsigned v) { return __hip_atomic_fetch_add(p, v, __ATOMIC_RELAXED, __HIP_MEMORY_SCOPE_AGENT); }
__device__ __forceinline__ unsigned xb_xcc_id() { return (unsigned)__builtin_amdgcn_s_getreg((3 << 11) | 20) & 0xFu; }
#define XB_SPIN(cond, bar) do { unsigned _sp = 0; while (cond) { __builtin_amdgcn_s_sleep(1); \
    if ((++_sp & 255u) == 0u) { if (xb_ld(&(bar)[XB_TMO])) break; if (_sp > XB_SPIN_CAP) { atomicAdd(&(bar)[XB_TMO], 1u); break; } } } } while (0)
struct XcdBarrier { unsigned* bar; unsigned x; volatile LAS unsigned* st; };
__device__ __forceinline__ XcdBarrier xcd_barrier_post(unsigned* bar, volatile LAS unsigned* st) {
    XcdBarrier b; b.bar = bar; b.x = xb_xcc_id(); b.st = st;
    if (threadIdx.x == 0) (void)xb_add(&bar[XB_XCNT(b.x)], 1u);
    return b;
}
__device__ __forceinline__ void xcd_barrier_complete(unsigned* bar, unsigned x, unsigned& nloc, unsigned& nx) {
    const unsigned G = gridDim.x * gridDim.y * gridDim.z;
    unsigned sum, cnt, mine, sp = 0u;
    for (;;) {
        sum = 0u; cnt = 0u; mine = 0u;
#pragma unroll
        for (unsigned j = 0; j < 16; ++j) { const unsigned c = xb_ld(&bar[XB_XCNT(j)]); sum += c; cnt += (c > 0u) ? 1u : 0u; mine = (j == x) ? c : mine; }
        if (sum == G) break;
        __builtin_amdgcn_s_sleep(1);
        if ((++sp & 255u) == 0u) { if (xb_ld(&bar[XB_TMO])) break; if (sp > XB_SPIN_CAP) { atomicAdd(&bar[XB_TMO], 1u); break; } }
    }
    nloc = mine > 0u ? mine : 1u; nx = cnt > 0u ? cnt : 1u;
}
__device__ __forceinline__ void xcd_barrier(const XcdBarrier& b) {
    asm volatile("s_waitcnt vmcnt(0)" ::: "memory");
    __syncthreads();
    if (threadIdx.x == 0) {
        unsigned* bar = b.bar;
        __builtin_amdgcn_s_waitcnt(0);
        unsigned nloc = b.st[0], nx = b.st[1];
        if (nloc == 0u) { xcd_barrier_complete(bar, b.x, nloc, nx); b.st[0] = nloc; b.st[1] = nx; }
        const unsigned old = xb_add(&bar[XB_XSUB(b.x)], 1u);
        const unsigned gen = old / nloc;
        if (old + 1u == (gen + 1u) * nloc) {
            __builtin_amdgcn_fence(__ATOMIC_RELEASE, "agent");
            asm volatile("s_waitcnt vmcnt(0)" ::: "memory");
            const unsigned og = xb_add(&bar[XB_TOP], 1u);
            const unsigned tg = og / nx;
            if (og + 1u == (tg + 1u) * nx) xb_add(&bar[XB_TOPGEN], 1u);
            else XB_SPIN(xb_ld(&bar[XB_TOPGEN]) == tg, bar);
            __builtin_amdgcn_fence(__ATOMIC_ACQUIRE, "agent");
            xb_add(&bar[XB_XGEN(b.x)], 1u);
            asm volatile("s_waitcnt vmcnt(0)" ::: "memory");
        } else {
            XB_SPIN(xb_ld(&bar[XB_XGEN(b.x)]) == gen, bar);
            __builtin_amdgcn_fence(__ATOMIC_ACQUIRE, "agent");
            asm volatile("s_waitcnt vmcnt(0)" ::: "memory");
        }
    }
    __syncthreads();
}

#define DPP_ROR_ADD(v, ctrl) v += __builtin_bit_cast(float, __builtin_amdgcn_update_dpp(0, __builtin_bit_cast(int, v), ctrl, 0xf, 0xf, false))
__device__ __forceinline__ float row16_allsum(float v) { DPP_ROR_ADD(v, 0x128); DPP_ROR_ADD(v, 0x124); DPP_ROR_ADD(v, 0x122); DPP_ROR_ADD(v, 0x121); return v; }
__device__ __forceinline__ float xor_add(float v, int lane, int m) { return v + __builtin_bit_cast(float, __builtin_amdgcn_ds_bpermute((lane ^ m) << 2, __builtin_bit_cast(int, v))); }
__device__ __forceinline__ float wave_sum(float v, int lane) { return xor_add(xor_add(row16_allsum(v), lane, 16), lane, 32); }
using pg8::Unit; using pg8::cvt_pk_bf16; using pg8::HALF; using pg8::BM;
typedef float f4 __attribute__((ext_vector_type(4)));
typedef float f2v __attribute__((ext_vector_type(2)));

__device__ __forceinline__ void load_rs(const float* ss, int pm, int wr, int fr, float (&rsv)[2][4]) {
#pragma unroll
    for (int ai = 0; ai < 2; ++ai)
#pragma unroll
        for (int m = 0; m < 4; ++m) { const int row = pm * BM + ai * HALF + wr * 64 + m * 16 + fr; const f4 p = *(const f4*)(ss + (size_t)row * 4);
            rsv[ai][m] = 1.0f / sqrtf(((p.x + p.y) + (p.z + p.w)) * (1.0f / D) + EPS); }
}

struct EpiGU {
    static constexpr bool PERM = true, AFTER_DRAIN = false, DRAINS = true;
    bf16* act; const float* ss; int nostore;
    __device__ __forceinline__ void operator()(const f4 (&acc)[2][2][4][2], const Unit& u, int wr, int wc, int fr, int fq) const {
        float rsv[2][4]; load_rs(ss, u.pm, wr, fr, rsv);
        asm volatile("s_waitcnt vmcnt(0)" ::: "memory");
        const int col0 = u.pn * 128 + wc * 32 + 8 * fq;
#pragma unroll
        for (int ai = 0; ai < 2; ++ai)
#pragma unroll
            for (int m = 0; m < 4; ++m) { const int row = u.pm * BM + ai * HALF + wr * 64 + m * 16 + fr; const float rs = rsv[ai][m];
                float h[8];
#pragma unroll
                for (int n = 0; n < 2; ++n)
#pragma unroll
                    for (int j = 0; j < 4; ++j) { const float g = acc[ai][0][m][n][j] * rs, up = acc[ai][1][m][n][j] * rs; h[n * 4 + j] = fast_silu(g) * up; }
                v4u w; w.x = cvt_pk_bf16(h[0], h[1]); w.y = cvt_pk_bf16(h[2], h[3]); w.z = cvt_pk_bf16(h[4], h[5]); w.w = cvt_pk_bf16(h[6], h[7]);
                if (nostore) { asm volatile("" :: "v"(w.x), "v"(w.y), "v"(w.z), "v"(w.w)); } else *(v4u*)(act + (size_t)row * FF + col0) = w; }
    }
};

struct EpiWin {
    static constexpr bool PERM = true, AFTER_DRAIN = false, DRAINS = true;
    unsigned char* ws; const float* ss;
    __device__ __forceinline__ void operator()(const f4 (&acc)[2][2][4][2], const Unit& u, int wr, int wc, int fr, int fq) const {
        float rsv[2][4]; load_rs(ss, u.pm, wr, fr, rsv);
        asm volatile("s_waitcnt vmcnt(0)" ::: "memory");
        const int pn = u.pn;
        int mode, ld, colt; bf16* base;
        if (pn < 2) { mode = 0; base = (bf16*)(ws + WS_UPOOL); ld = 512; colt = pn * 256; }
        else if (pn < 4) { mode = 1; base = (bf16*)(ws + WS_Q); ld = 512; colt = (pn - 2) * 256; }
        else if (pn < 6) { mode = 2; base = (bf16*)(ws + WS_F); ld = 512; colt = (pn - 4) * 256; }
        else if (pn < 8) { mode = 0; base = (bf16*)(ws + WS_V); ld = 512; colt = (pn - 6) * 256; }
        else if (pn < 10) { mode = 1; base = (bf16*)(ws + WS_OG); ld = 512; colt = (pn - 8) * 256; }
        else { mode = 3; base = (bf16*)(ws + WS_GATES); ld = 2048; colt = (pn - 10) * 256; }
        const int col0 = colt + wc * 32 + 8 * fq;
#pragma unroll
        for (int ai = 0; ai < 2; ++ai)
#pragma unroll
            for (int m = 0; m < 4; ++m) { const int row = u.pm * BM + ai * HALF + wr * 64 + m * 16 + fr; const float rs = rsv[ai][m];
#pragma unroll
                for (int bj = 0; bj < 2; ++bj) {
                    float z[8];
#pragma unroll
                    for (int n = 0; n < 2; ++n)
#pragma unroll
                        for (int j = 0; j < 4; ++j) z[n * 4 + j] = acc[ai][bj][m][n][j] * rs;
                    v4u w;
                    if (mode == 2) { w.x = pkh2(z[0], z[1]); w.y = pkh2(z[2], z[3]); w.z = pkh2(z[4], z[5]); w.w = pkh2(z[6], z[7]); }
                    else {
                        if (mode == 1) {
#pragma unroll
                            for (int e = 0; e < 8; ++e) z[e] = fast_silu(z[e]);
                        } else if (mode == 3) {
#pragma unroll
                            for (int e = 0; e < 8; ++e) z[e] = fast_sigmoid(z[e]);
                        }
                        w.x = cvt_pk_bf16(z[0], z[1]); w.y = cvt_pk_bf16(z[2], z[3]); w.z = cvt_pk_bf16(z[4], z[5]); w.w = cvt_pk_bf16(z[6], z[7]);
                    }
                    *(v4u*)(base + (size_t)row * ld + col0 + bj * HALF) = w; } }
    }
};

struct EpiX {
    static constexpr bool PERM = true, AFTER_DRAIN = true, DRAINS = false;
    const float* xin; float* xout; bf16* xb; float* ss; float coef;
    __device__ __forceinline__ void fused(f4 (&acc)[2][2][4][2], const Unit& u, int wr, int wc, int fr, int fq, PG8_LAS unsigned char* lds, int wid, int lane) const {
        PG8_LAS float* P = (PG8_LAS float*)lds;
        const int col0 = u.pn * BM + wc * 32 + 8 * fq;
#pragma unroll
        for (int ai = 0; ai < 2; ++ai)
#pragma unroll
            for (int m = 0; m < 4; ++m) { const int rl = ai * HALF + wr * 64 + m * 16 + fr; const size_t off = (size_t)(u.pm * BM + rl) * D + col0;
                float s = 0.f;
#pragma unroll
                for (int bj = 0; bj < 2; ++bj) {
                    const f4 x0 = *(const f4*)(xin + off + bj * HALF), x1 = *(const f4*)(xin + off + bj * HALF + 4);
                    const f4 y0 = x0 + acc[ai][bj][m][0] * coef, y1 = x1 + acc[ai][bj][m][1] * coef;
                    *(f4*)(xout + off + bj * HALF) = y0; *(f4*)(xout + off + bj * HALF + 4) = y1;
                    v4u w; w.x = cvt_pk_bf16(y0[0], y0[1]); w.y = cvt_pk_bf16(y0[2], y0[3]); w.z = cvt_pk_bf16(y1[0], y1[1]); w.w = cvt_pk_bf16(y1[2], y1[3]);
                    *(v4u*)(xb + off + bj * HALF) = w;
                    s += (y0[0] * y0[0] + y0[1] * y0[1]) + (y0[2] * y0[2] + y0[3] * y0[3]) + (y1[0] * y1[0] + y1[1] * y1[1]) + (y1[2] * y1[2] + y1[3] * y1[3]); }
                s = xor_add(xor_add(s, lane, 16), lane, 32);
                if (fq == 0) P[rl * 4 + wc] = s; }
        asm volatile("s_waitcnt lgkmcnt(0)" ::: "memory"); __builtin_amdgcn_s_barrier(); asm volatile("" ::: "memory");
        const int t = wid * 64 + lane;
        if (t < 256) { const float a = P[t * 4 + 0], b = P[t * 4 + 1], c = P[t * 4 + 2], d = P[t * 4 + 3]; ss[(size_t)(u.pm * BM + t) * 4 + u.pn] = (a + b) + (c + d); }
        asm volatile("s_waitcnt lgkmcnt(0)" ::: "memory"); __builtin_amdgcn_s_barrier(); asm volatile("" ::: "memory");
    }
};

struct EpiProj {
    static constexpr bool PERM = true, AFTER_DRAIN = false, DRAINS = false;
    const bf16* gates; bf16* merged;
    __device__ __forceinline__ void operator()(const f4 (&acc)[2][2][4][2], const Unit& u, int wr, int wc, int fr, int fq) const {
        const int col0 = u.pn * BM + wc * 32 + 8 * fq;
#pragma unroll
        for (int ai = 0; ai < 2; ++ai)
#pragma unroll
            for (int m = 0; m < 4; ++m) { const int row = u.pm * BM + ai * HALF + wr * 64 + m * 16 + fr;
#pragma unroll
                for (int bj = 0; bj < 2; ++bj) {
                    const v4u g = *(const v4u*)(gates + (size_t)row * 2048 + (u.kind ? 1024 : 0) + col0 + bj * HALF);
                    bf16* mp = merged + (size_t)row * D + col0 + bj * HALF;
                    float y[8];
                    y[0] = bflo(g.x) * acc[ai][bj][m][0][0]; y[1] = bfhi(g.x) * acc[ai][bj][m][0][1]; y[2] = bflo(g.y) * acc[ai][bj][m][0][2]; y[3] = bfhi(g.y) * acc[ai][bj][m][0][3];
                    y[4] = bflo(g.z) * acc[ai][bj][m][1][0]; y[5] = bfhi(g.z) * acc[ai][bj][m][1][1]; y[6] = bflo(g.w) * acc[ai][bj][m][1][2]; y[7] = bfhi(g.w) * acc[ai][bj][m][1][3];
                    if (u.kind) { const v4u t = *(const v4u*)mp;
                        y[0] += bflo(t.x); y[1] += bfhi(t.x); y[2] += bflo(t.y); y[3] += bfhi(t.y); y[4] += bflo(t.z); y[5] += bfhi(t.z); y[6] += bflo(t.w); y[7] += bfhi(t.w); }
                    v4u w; w.x = cvt_pk_bf16(y[0], y[1]); w.y = cvt_pk_bf16(y[2], y[3]); w.z = cvt_pk_bf16(y[4], y[5]); w.w = cvt_pk_bf16(y[6], y[7]);
                    *(v4u*)mp = w; } }
    }
};


struct TrItem { const float* W; bf16* WT; const float* gain; int K, N, rowmode, item; };
__device__ __forceinline__ void tr_load(const TrItem& t, int lane, f32x4 (&v)[16], f32x4 (&g)[4]) {
    const int nblk = t.N / 64, kb = t.item / nblk, nb = t.item % nblk, k0 = 64 * kb, n0 = 64 * nb, r = lane >> 4, c4 = lane & 15;
    const float* src = t.W + (size_t)(k0 + 16 * r) * t.N + n0 + 4 * c4;
#pragma unroll
    for (int i = 0; i < 16; ++i) v[i] = *(const GAS f32x4*)(src + (size_t)i * t.N);
#pragma unroll
    for (int q = 0; q < 4; ++q) g[q] = t.gain ? *(const GAS f32x4*)(t.gain + k0 + 16 * r + 4 * q) : (f32x4){1.f, 1.f, 1.f, 1.f};
}
__device__ __forceinline__ void tr_store(const TrItem& t, int lane, const f32x4 (&v)[16], const f32x4 (&g)[4], LAS unsigned short* scr) {
    const int nblk = t.N / 64, kb = t.item / nblk, nb = t.item % nblk, k0 = 64 * kb, n0 = 64 * nb, r = lane >> 4, c4 = lane & 15;
#pragma unroll
    for (int j = 0; j < 4; ++j) { v4u a, c;
        a.x = pk2(v[0][j] * g[0][0], v[1][j] * g[0][1]); a.y = pk2(v[2][j] * g[0][2], v[3][j] * g[0][3]); a.z = pk2(v[4][j] * g[1][0], v[5][j] * g[1][1]); a.w = pk2(v[6][j] * g[1][2], v[7][j] * g[1][3]);
        c.x = pk2(v[8][j] * g[2][0], v[9][j] * g[2][1]); c.y = pk2(v[10][j] * g[2][2], v[11][j] * g[2][3]); c.z = pk2(v[12][j] * g[3][0], v[13][j] * g[3][1]); c.w = pk2(v[14][j] * g[3][2], v[15][j] * g[3][3]);
        LAS unsigned short* d = scr + (4 * c4 + j) * 72 + 16 * r; *(LAS v4u*)d = a; *(LAS v4u*)(d + 8) = c; }
    LDS_WAIT(); asm volatile("" ::: "memory");
    const int c8 = lane & 7;
#pragma unroll
    for (int q = 0; q < 8; ++q) { const int n = (lane >> 3) + 8 * q; const v4u o = *(const LAS v4u*)(scr + n * 72 + 8 * c8);
        const int nn = n0 + n; const int orow = t.rowmode == 0 ? nn : (256 * (nn >> 7) + (nn & 127) + (t.rowmode == 2 ? 128 : 0));
        *(GAS v4u*)(t.WT + (size_t)orow * t.K + k0 + 8 * c8) = o; }
    LDS_WAIT(); asm volatile("" ::: "memory");
}

struct Args { const float* in[19]; float* out; unsigned char* ws; int nph, pad; unsigned char plist[64]; };

__device__ __forceinline__ bool conv_item(const Args& a, int l, int it, TrItem& t) {
    unsigned char* ws = a.ws;
    constexpr int I_GU = (D / 64) * (FF / 64), I_DN = (FF / 64) * (D / 64), I_IN = (D / 64) * (DIN / 64), I_PR = (PW / 64) * (D / 64), I_OUT = (D / 64) * (D / 64), I_PL = 4 * 2 * 2;
    constexpr int NITEMS = 4 * I_GU + 2 * I_DN + I_IN + 2 * I_PR + I_OUT + I_PL;
    if (it >= NITEMS) return false;
    int r = it;
    if (r < I_GU) { t = TrItem{a.in[2] + (size_t)l * D * FF, (bf16*)(ws + WS_WGU1), a.in[1] + l * D, D, FF, 1, r}; return true; } r -= I_GU;
    if (r < I_GU) { t = TrItem{a.in[3] + (size_t)l * D * FF, (bf16*)(ws + WS_WGU1), a.in[1] + l * D, D, FF, 2, r}; return true; } r -= I_GU;
    if (r < I_GU) { t = TrItem{a.in[15] + (size_t)l * D * FF, (bf16*)(ws + WS_WGU2), a.in[14] + l * D, D, FF, 1, r}; return true; } r -= I_GU;
    if (r < I_GU) { t = TrItem{a.in[16] + (size_t)l * D * FF, (bf16*)(ws + WS_WGU2), a.in[14] + l * D, D, FF, 2, r}; return true; } r -= I_GU;
    if (r < I_DN) { t = TrItem{a.in[4] + (size_t)l * FF * D, (bf16*)(ws + WS_WD1), nullptr, FF, D, 0, r}; return true; } r -= I_DN;
    if (r < I_DN) { t = TrItem{a.in[17] + (size_t)l * FF * D, (bf16*)(ws + WS_WD2), nullptr, FF, D, 0, r}; return true; } r -= I_DN;
    if (r < I_IN) { t = TrItem{a.in[6] + (size_t)l * D * DIN, (bf16*)(ws + WS_WIN), a.in[5] + l * D, D, DIN, 0, r}; return true; } r -= I_IN;
    if (r < I_PR) { t = TrItem{a.in[11] + (size_t)l * PW * D, (bf16*)(ws + WS_WPA), nullptr, PW, D, 0, r}; return true; } r -= I_PR;
    if (r < I_PR) { t = TrItem{a.in[12] + (size_t)l * HG * D, (bf16*)(ws + WS_WPB), nullptr, HG, D, 0, r}; return true; } r -= I_PR;
    if (r < I_OUT) { t = TrItem{a.in[13] + (size_t)l * D * D, (bf16*)(ws + WS_WOUT), nullptr, D, D, 0, r}; return true; } r -= I_OUT;
    { const int g = r / 4; t = TrItem{a.in[7] + (size_t)(l * 4 + g) * 128 * 128, (bf16*)(ws + WS_POOLW) + (size_t)g * 128 * 128, nullptr, 128, 128, 0, r % 4}; return true; }
}
__device__ __forceinline__ void convert_weights(const Args& a, int l, LAS unsigned char* lds, int gw, int NGW, int wave, int lane) {
    LAS unsigned short* scr = (LAS unsigned short*)(lds + RING_OFF + wave * 16384);
    TrItem cur, nxt; f32x4 va[16], ga[4], vb[16], gb[4];
    int it = gw; bool have = conv_item(a, l, it, cur);
    if (have) tr_load(cur, lane, va, ga);
    while (have) {
        const bool hn = conv_item(a, l, it + NGW, nxt);
        if (hn) tr_load(nxt, lane, vb, gb);
        tr_store(cur, lane, va, ga, scr);
        if (!hn) break;
        it += 2 * NGW;
        have = conv_item(a, l, it, cur);
        if (have) tr_load(cur, lane, va, ga);
        tr_store(nxt, lane, vb, gb, scr);
    }
}

__device__ __forceinline__ void x_to_bf16_ss(const float* x, bf16* xb, float* ss, int gw, int NGW, int lane) {
    for (int m = gw; m < M; m += NGW) {
        const GAS f32x4* xr = (const GAS f32x4*)(x + (size_t)m * D) + lane;
        f32x4 v[4]; float s = 0.f;
#pragma unroll
        for (int j = 0; j < 4; ++j) { v[j] = xr[64 * j]; s += (v[j].x * v[j].x + v[j].y * v[j].y) + (v[j].z * v[j].z + v[j].w * v[j].w); }
        s = wave_sum(s, lane);
        GAS unsigned long long* o8 = (GAS unsigned long long*)(xb + (size_t)m * D) + lane;
#pragma unroll
        for (int j = 0; j < 4; ++j) o8[64 * j] = (unsigned long long)pk2(v[j].x, v[j].y) | ((unsigned long long)pk2(v[j].z, v[j].w) << 32);
        if (lane == 0) *(GAS f32x4*)(ss + (size_t)m * 4) = (f32x4){s, 0.f, 0.f, 0.f};
    }
}

__device__ __forceinline__ void final_norm(float* x, const float* g, int gw, int NGW, int lane) {
    f32x4 gv[4];
#pragma unroll
    for (int j = 0; j < 4; ++j) gv[j] = ((const GAS f32x4*)g)[lane + 64 * j];
    for (int m = gw; m < M; m += NGW) {
        GAS f32x4* xr = (GAS f32x4*)(x + (size_t)m * D) + lane;
        f32x4 v[4]; float s = 0.f;
#pragma unroll
        for (int j = 0; j < 4; ++j) { v[j] = xr[64 * j]; s += (v[j].x * v[j].x + v[j].y * v[j].y) + (v[j].z * v[j].z + v[j].w * v[j].w); }
        const float rs = 1.0f / sqrtf(wave_sum(s, lane) * (1.0f / D) + EPS);
#pragma unroll
        for (int j = 0; j < 4; ++j) xr[64 * j] = v[j] * rs * gv[j];
    }
}

__device__ __forceinline__ float lb_of(const float* lb_logits, int l, int c) {
    if (l == 0) return 0.f;
    const float l0 = lb_logits[c], l1 = lb_logits[HG + c];
    return 1.0f / (1.0f + expf(l0 - l1));
}

typedef __bf16 bf16x2_t __attribute__((ext_vector_type(2)));
__device__ __forceinline__ unsigned pkc(float lo, float hi) { const bf16x2_t r = __builtin_convertvector((f2v){lo, hi}, bf16x2_t); return __builtin_bit_cast(unsigned, r); }
typedef short bf16x8 __attribute__((ext_vector_type(8)));
__device__ __forceinline__ f4 mfma16(bf16x8 x, bf16x8 y, f4 c) { return __builtin_amdgcn_mfma_f32_16x16x32_bf16(x, y, c, 0, 0, 0); }
__device__ __forceinline__ void wg_barrier() { asm volatile("s_waitcnt vmcnt(0) lgkmcnt(0)" ::: "memory"); __builtin_amdgcn_s_barrier(); asm volatile("" ::: "memory"); }

template <int W>
__device__ __forceinline__ void pool_window(const bf16* up  , int pos0, LAS unsigned short* Ds, int j, int ch) {
    float uu[31];
#pragma unroll
    for (int x = 0; x < 31; ++x) { uu[x] = 0.f; if (x >= 16 - W && pos0 - 15 + x >= 0) uu[x] = bf2f(up[(long)(x - 15) * PW]); }
#pragma unroll
    for (int i = 0; i < 16; ++i) { float sm = 0.f;
#pragma unroll
        for (int k = 0; k < W; ++k) sm += uu[15 + i - k];
        const int cnt = (pos0 + i + 1 < W) ? (pos0 + i + 1) : W;
        const float d = sm / (float)cnt - uu[15 + i];
        Ds[(16 * j + i) * 136 + ch] = (unsigned short)f2bf(d); }
}
__device__ __forceinline__ void pool_items(const bf16* upool, const bf16* poolwT, const float* pool_scale, bf16* pool_out, LAS unsigned char* lds, int vcu, int G, int tid_in) {
    LAS unsigned short* Ds = (LAS unsigned short*)lds;
    for (int it = vcu; it < (M / 64) * 4; it += G) {
        int tid = tid_in; asm volatile("" : "+v"(tid));
        const int lane = tid & 63, w = __builtin_amdgcn_readfirstlane(tid >> 6), fr = lane & 15, fq = lane >> 4, ch = tid & 127, j = tid >> 7;
        const int g = it & 3, row0 = (it >> 2) * 64, r0 = row0 + 16 * j, pos0 = r0 & (SEQ - 1);
        const bf16* up = upool + (size_t)r0 * PW + g * 128 + ch;
        if (g == 0) pool_window<2>(up, pos0, Ds, j, ch); else if (g == 1) pool_window<4>(up, pos0, Ds, j, ch); else if (g == 2) pool_window<8>(up, pos0, Ds, j, ch); else pool_window<16>(up, pos0, Ds, j, ch);
        wg_barrier();
        const int tt = w & 3, dh = w >> 2;
        bf16x8 yd[4];
#pragma unroll
        for (int ks = 0; ks < 4; ++ks) yd[ks] = *(const LAS bf16x8*)(Ds + (16 * tt + fr) * 136 + 32 * ks + 8 * fq);
#pragma unroll
        for (int dt = 0; dt < 4; ++dt) { const int dout0 = 16 * (4 * dh + dt); f4 acc = (f4){0.f, 0.f, 0.f, 0.f};
#pragma unroll
            for (int ks = 0; ks < 4; ++ks) { const bf16x8 xa = *(const bf16x8*)(poolwT + ((size_t)(g * 128 + dout0 + fr) * 128 + 32 * ks + 8 * fq)); acc = mfma16(xa, yd[ks], acc); }
            const f4 ps = *(const f4*)(pool_scale + g * 128 + dout0 + 4 * fq);
            v2u o; o.x = pkc(acc[0] * ps[0], acc[1] * ps[1]); o.y = pkc(acc[2] * ps[2], acc[3] * ps[3]);
            *(v2u*)(pool_out + (size_t)(row0 + 16 * tt + fr) * PW + g * 128 + dout0 + 4 * fq) = o; }
        wg_barrier();
    }
}

__device__ __forceinline__ void gate_fk(float z, float lb, float& f, float& k) {
    const float e = __expf(-fabsf(z)), r = __builtin_amdgcn_rcpf(1.0f + e), er = e * r;
    const float sg = z >= 0.f ? r : er, sm = z >= 0.f ? er : r;
    f = lb + (1.0f - lb) * sg; k = (1.0f - lb) * sm;
}
__device__ __forceinline__ v4u pack8(const float (&x)[8]) { v4u w; w.x = pkc(x[0], x[1]); w.y = pkc(x[2], x[3]); w.z = pkc(x[4], x[5]); w.w = pkc(x[6], x[7]); return w; }

__device__ __forceinline__ void hgrn_u_items(const bf16* F, const bf16* V, const float* lb_logits, int l, bf16* UT, float* DEC, LAS unsigned char* lds, int vcu, int G, int tid_in) {
    LAS unsigned short* vT = (LAS unsigned short*)lds; LAS unsigned short* keT = vT + 128 * 72; LAS float* TOT = (LAS float*)(lds + 2 * 128 * 72 * 2);
    for (int item = vcu; item < BATCH * NH * (SEQ / 64); item += G) {
        int tid = tid_in; asm volatile("" : "+v"(tid));
        const int lane = tid & 63, w = __builtin_amdgcn_readfirstlane(tid >> 6), fr = lane & 15, fq = lane >> 4, ch = tid & 127, j = tid >> 7;
        const int bh = item >> 7, n = item & 127, b = bh >> 2, h = bh & 3, hc = h * 128 + ch;
        const size_t row0 = (size_t)b * SEQ + n * 64 + 16 * j;
        const float lb = lb_of(lb_logits, l, hc);
        unsigned short fz[16], vv[16];
#pragma unroll
        for (int i = 0; i < 16; ++i) { fz[i] = F[(row0 + i) * HG + hc]; vv[i] = V[(row0 + i) * HG + hc]; }
        float ks[16]; float S = 1.0f;
#pragma unroll
        for (int i = 15; i >= 0; --i) { float f, k; gate_fk(h2f(fz[i]), lb, f, k); ks[i] = k * S; S *= f; }
        TOT[j * 128 + ch] = S;
        { v4u a, c; a.x = vv[0] | ((unsigned)vv[1] << 16); a.y = vv[2] | ((unsigned)vv[3] << 16); a.z = vv[4] | ((unsigned)vv[5] << 16); a.w = vv[6] | ((unsigned)vv[7] << 16);
          c.x = vv[8] | ((unsigned)vv[9] << 16); c.y = vv[10] | ((unsigned)vv[11] << 16); c.z = vv[12] | ((unsigned)vv[13] << 16); c.w = vv[14] | ((unsigned)vv[15] << 16);
          *(LAS v4u*)(vT + ch * 72 + 16 * j) = a; *(LAS v4u*)(vT + ch * 72 + 16 * j + 8) = c; }
        wg_barrier();
        { float sc = 1.0f;
#pragma unroll
          for (int m = 1; m < 4; ++m) if (m > j) sc *= TOT[m * 128 + ch];
          float x0[8], x1[8];
#pragma unroll
          for (int i = 0; i < 8; ++i) { x0[i] = ks[i] * sc; x1[i] = ks[8 + i] * sc; }
          *(LAS v4u*)(keT + ch * 72 + 16 * j) = pack8(x0); *(LAS v4u*)(keT + ch * 72 + 16 * j + 8) = pack8(x1);
          if (j == 0) DEC[(size_t)item * 128 + ch] = (TOT[ch] * TOT[128 + ch]) * (TOT[256 + ch] * TOT[384 + ch]); }
        wg_barrier();
        bf16x8 yb[2];
#pragma unroll
        for (int ksx = 0; ksx < 2; ++ksx) yb[ksx] = *(const LAS bf16x8*)(vT + (16 * w + fr) * 72 + 32 * ksx + 8 * fq);
        bf16* up = UT + ((size_t)item * 128 + 16 * w + fr) * 128 + 4 * fq;
#pragma unroll
        for (int dkt = 0; dkt < 8; ++dkt) { f4 acc = (f4){0.f, 0.f, 0.f, 0.f};
#pragma unroll
            for (int ksx = 0; ksx < 2; ++ksx) { const bf16x8 xa = *(const LAS bf16x8*)(keT + (16 * dkt + fr) * 72 + 32 * ksx + 8 * fq); acc = mfma16(xa, yb[ksx], acc); }
            v2u o; o.x = pkc(acc[0], acc[1]); o.y = pkc(acc[2], acc[3]);
            *(v2u*)(up + 16 * dkt) = o; }
        wg_barrier();
    }
}

__device__ __forceinline__ void hgrn_scan(bf16* UT, const float* DEC, int vcu, int tid) {
    if (tid >= 256) return;
    const int e = vcu * 256 + tid; if (e >= BATCH * NH * 128 * 64) return;
    const int dkp = e & 63, dv = (e >> 6) & 127, bh = e >> 13;
    unsigned* p = (unsigned*)(UT + ((size_t)bh * 128 * 128 + dv) * 128 + 2 * dkp);
    const f2v* dp = (const f2v*)(DEC + (size_t)bh * 128 * 128 + 2 * dkp);
    float s0 = 0.f, s1 = 0.f;
    for (int n0 = 0; n0 < 128; n0 += 8) {
        unsigned u[8]; f2v d[8];
#pragma unroll
        for (int i = 0; i < 8; ++i) { u[i] = p[(size_t)(n0 + i) * (128 * 128 / 2)]; d[i] = dp[(size_t)(n0 + i) * 64]; }
#pragma unroll
        for (int i = 0; i < 8; ++i) { p[(size_t)(n0 + i) * (128 * 128 / 2)] = pkc(s0, s1); s0 = d[i].x * s0 + bflo(u[i]); s1 = d[i].y * s1 + bfhi(u[i]); }
    }
}

constexpr int MC_QS = 0, MC_FS = MC_QS + 64 * 136 * 2, MC_KS = MC_FS + 64 * 132 * 4, MC_VT = MC_KS + 64 * 132 * 4, MC_TOT = MC_VT + 128 * 72 * 2, MC_AD = MC_TOT + 4 * 128 * 4, MC_PS = MC_AD + 4 * 16 * 20 * 4, MC_END = MC_PS + 2 * 64 * 4;
static_assert(MC_END <= RING_BYTES, "MIXC LDS");
__device__ __forceinline__ void hgrn_o_items(const bf16* Q, const bf16* F, const bf16* V, const bf16* OGs, const float* lb_logits, const float* hn, int l, const bf16* SPT, bf16* hout, LAS unsigned char* lds, int vcu, int G, int tid_in) {
    LAS unsigned short* Qs = (LAS unsigned short*)(lds + MC_QS); LAS float* Fs = (LAS float*)(lds + MC_FS); LAS float* Ks = (LAS float*)(lds + MC_KS);
    LAS unsigned short* vT = (LAS unsigned short*)(lds + MC_VT); LAS float* TOT = (LAS float*)(lds + MC_TOT); LAS float* AD = (LAS float*)(lds + MC_AD); LAS float* PS = (LAS float*)(lds + MC_PS);
    for (int item = vcu; item < BATCH * NH * (SEQ / 64); item += G) {
        int tid = tid_in; asm volatile("" : "+v"(tid));
        const int lane = tid & 63, w = __builtin_amdgcn_readfirstlane(tid >> 6), fr = lane & 15, fq = lane >> 4, ch = tid & 127, j = tid >> 7;
        const int wi = w & 3, h2 = w >> 2;
        const int bh = item >> 7, n = item & 127, b = bh >> 2, h = bh & 3, hc = h * 128 + ch;
        const size_t crow0 = (size_t)b * SEQ + n * 64;
        { const float lb = lb_of(lb_logits, l, hc); const size_t row0 = crow0 + 16 * j;
          unsigned short fz[16], vv[16], qq[16];
#pragma unroll
          for (int i = 0; i < 16; ++i) { fz[i] = F[(row0 + i) * HG + hc]; vv[i] = V[(row0 + i) * HG + hc]; qq[i] = Q[(row0 + i) * HG + hc]; }
#pragma unroll
          for (int i = 0; i < 16; ++i) { float f, k; gate_fk(h2f(fz[i]), lb, f, k); Fs[(16 * j + i) * 132 + ch] = f; Ks[(16 * j + i) * 132 + ch] = k; Qs[(16 * j + i) * 136 + ch] = qq[i]; }
          v4u a, c; a.x = vv[0] | ((unsigned)vv[1] << 16); a.y = vv[2] | ((unsigned)vv[3] << 16); a.z = vv[4] | ((unsigned)vv[5] << 16); a.w = vv[6] | ((unsigned)vv[7] << 16);
          c.x = vv[8] | ((unsigned)vv[9] << 16); c.y = vv[10] | ((unsigned)vv[11] << 16); c.z = vv[12] | ((unsigned)vv[13] << 16); c.w = vv[14] | ((unsigned)vv[15] << 16);
          *(LAS v4u*)(vT + ch * 72 + 16 * j) = a; *(LAS v4u*)(vT + ch * 72 + 16 * j + 8) = c; }
        wg_barrier();
        { const int sl = tid & 15, tp = (tid >> 4) & 7, i2 = tid >> 7, t1 = 15 - tp;
          float q0[8], q1[8], D0[8], D1[8];
          { const v4u a = *(const LAS v4u*)(Qs + (16 * i2 + tp) * 136 + 8 * sl), c = *(const LAS v4u*)(Qs + (16 * i2 + t1) * 136 + 8 * sl);
            q0[0] = bflo(a.x); q0[1] = bfhi(a.x); q0[2] = bflo(a.y); q0[3] = bfhi(a.y); q0[4] = bflo(a.z); q0[5] = bfhi(a.z); q0[6] = bflo(a.w); q0[7] = bfhi(a.w);
            q1[0] = bflo(c.x); q1[1] = bfhi(c.x); q1[2] = bflo(c.y); q1[3] = bfhi(c.y); q1[4] = bflo(c.z); q1[5] = bfhi(c.z); q1[6] = bflo(c.w); q1[7] = bfhi(c.w); }
#pragma unroll
          for (int e = 0; e < 8; ++e) { D0[e] = 1.0f; D1[e] = 1.0f; }
          LAS float* ad0 = AD + (i2 * 16 + tp) * 20; LAS float* ad1 = AD + (i2 * 16 + t1) * 20;
#pragma unroll 1
          for (int s = 15; s >= 8; --s) {
              const f4 k0 = *(const LAS f4*)(Ks + (16 * i2 + s) * 132 + 8 * sl), k1 = *(const LAS f4*)(Ks + (16 * i2 + s) * 132 + 8 * sl + 4);
              const f4 f0 = *(const LAS f4*)(Fs + (16 * i2 + s) * 132 + 8 * sl), f1 = *(const LAS f4*)(Fs + (16 * i2 + s) * 132 + 8 * sl + 4);
              const float kk[8] = {k0[0], k0[1], k0[2], k0[3], k1[0], k1[1], k1[2], k1[3]}, ff[8] = {f0[0], f0[1], f0[2], f0[3], f1[0], f1[1], f1[2], f1[3]};
              const bool on = s <= t1; float sm = 0.f;
#pragma unroll
              for (int e = 0; e < 8; ++e) { sm += q1[e] * kk[e] * D1[e]; D1[e] = on ? D1[e] * ff[e] : D1[e]; }
              sm = row16_allsum(on ? sm : 0.f);
              if (sl == 0) { ad1[s] = sm; ad0[s] = 0.f; }
          }
#pragma unroll 1
          for (int s = 7; s >= 0; --s) {
              const f4 k0 = *(const LAS f4*)(Ks + (16 * i2 + s) * 132 + 8 * sl), k1 = *(const LAS f4*)(Ks + (16 * i2 + s) * 132 + 8 * sl + 4);
              const f4 f0 = *(const LAS f4*)(Fs + (16 * i2 + s) * 132 + 8 * sl), f1 = *(const LAS f4*)(Fs + (16 * i2 + s) * 132 + 8 * sl + 4);
              const float kk[8] = {k0[0], k0[1], k0[2], k0[3], k1[0], k1[1], k1[2], k1[3]}, ff[8] = {f0[0], f0[1], f0[2], f0[3], f1[0], f1[1], f1[2], f1[3]};
              const bool on = s <= tp; float sm1 = 0.f, sm0 = 0.f;
#pragma unroll
              for (int e = 0; e < 8; ++e) { sm1 += q1[e] * kk[e] * D1[e]; D1[e] *= ff[e]; sm0 += q0[e] * kk[e] * D0[e]; D0[e] = on ? D0[e] * ff[e] : D0[e]; }
              sm1 = row16_allsum(sm1); sm0 = row16_allsum(on ? sm0 : 0.f);
              if (sl == 0) { ad1[s] = sm1; ad0[s] = sm0; }
          }
        }
        wg_barrier();
        bf16x8 spf[4][4];
#pragma unroll
        for (int d = 0; d < 4; ++d)
#pragma unroll
            for (int ksx = 0; ksx < 4; ++ksx) spf[d][ksx] = *(const bf16x8*)(SPT + ((size_t)item * 128 + 16 * (4 * h2 + d) + fr) * 128 + 32 * ksx + 8 * fq);
        { float fl[16];
#pragma unroll
          for (int i = 0; i < 16; ++i) fl[i] = Fs[(16 * j + i) * 132 + ch];
          float P = 1.0f;
#pragma unroll
          for (int i = 0; i < 16; ++i) { P *= fl[i]; const float qv = bf2f(Qs[(16 * j + i) * 136 + ch]); Qs[(16 * j + i) * 136 + ch] = (unsigned short)f2bf(qv * P); }
          float S = 1.0f;
#pragma unroll
          for (int i = 15; i >= 0; --i) { const float kv = Ks[(16 * j + i) * 132 + ch]; Ks[(16 * j + i) * 132 + ch] = kv * S; S *= fl[i]; }
          TOT[j * 128 + ch] = S; }
        wg_barrier();
        f4 acc[4];
#pragma unroll
        for (int d = 0; d < 4; ++d) acc[d] = (f4){0.f, 0.f, 0.f, 0.f};
        bf16x8 qr[4];
        f4 AT[3];
#pragma unroll
        for (int jj = 0; jj < 3; ++jj) AT[jj] = (f4){0.f, 0.f, 0.f, 0.f};
#pragma unroll
        for (int ksx = 0; ksx < 4; ++ksx) { const int dk0 = 32 * ksx + 8 * fq;
            const f4 ta0 = *(const LAS f4*)(TOT + dk0), ta1 = *(const LAS f4*)(TOT + dk0 + 4), tb0 = *(const LAS f4*)(TOT + 128 + dk0), tb1 = *(const LAS f4*)(TOT + 128 + dk0 + 4), tc0 = *(const LAS f4*)(TOT + 256 + dk0), tc1 = *(const LAS f4*)(TOT + 256 + dk0 + 4);
            const float T0[8] = {ta0[0], ta0[1], ta0[2], ta0[3], ta1[0], ta1[1], ta1[2], ta1[3]}, T1[8] = {tb0[0], tb0[1], tb0[2], tb0[3], tb1[0], tb1[1], tb1[2], tb1[3]}, T2[8] = {tc0[0], tc0[1], tc0[2], tc0[3], tc1[0], tc1[1], tc1[2], tc1[3]};
            const v4u qw = *(const LAS v4u*)(Qs + (16 * wi + fr) * 136 + dk0);
            qr[ksx] = __builtin_bit_cast(bf16x8, qw);
            float R[8], qf[8] = {bflo(qw.x), bfhi(qw.x), bflo(qw.y), bfhi(qw.y), bflo(qw.z), bfhi(qw.z), bflo(qw.w), bfhi(qw.w)};
#pragma unroll
            for (int e = 0; e < 8; ++e) { R[e] = (wi >= 1 ? T0[e] : 1.0f) * (wi >= 2 ? T1[e] : 1.0f) * (wi >= 3 ? T2[e] : 1.0f); qf[e] *= R[e]; }
            const bf16x8 qe = __builtin_bit_cast(bf16x8, pack8(qf));
#pragma unroll
            for (int d = 0; d < 4; ++d) acc[d] = mfma16(spf[d][ksx], qe, acc[d]);
#pragma unroll
            for (int jj = 0; jj < 3; ++jj) if (jj < wi) {
                const f4 c0 = *(const LAS f4*)(Ks + (16 * jj + fr) * 132 + dk0), c1 = *(const LAS f4*)(Ks + (16 * jj + fr) * 132 + dk0 + 4);
                float kr[8] = {c0[0], c0[1], c0[2], c0[3], c1[0], c1[1], c1[2], c1[3]};
#pragma unroll
                for (int e = 0; e < 8; ++e) { float sc = 1.0f; if (jj < 1 && wi > 1) sc *= T1[e]; if (jj < 2 && wi > 2) sc *= T2[e]; kr[e] *= sc; }
                AT[jj] = mfma16(__builtin_bit_cast(bf16x8, pack8(kr)), qr[ksx], AT[jj]); }
        }
        unsigned pk[4][2];
        { const f4 ad = *(const LAS f4*)(AD + (wi * 16 + fr) * 20 + 4 * fq);
#pragma unroll
          for (int jb = 0; jb < 4; ++jb) { f4 v = (f4){0.f, 0.f, 0.f, 0.f};
              if (jb < 3 && jb < wi) v = AT[jb < 3 ? jb : 0]; else if (jb == wi) v = ad;
              pk[jb][0] = pkc(v[0], v[1]); pk[jb][1] = pkc(v[2], v[3]); } }
#pragma unroll
        for (int kk = 0; kk < 2; ++kk) if (2 * kk <= wi) {
            v4u yv; yv.x = pk[2 * kk][0]; yv.y = pk[2 * kk][1]; yv.z = pk[2 * kk + 1][0]; yv.w = pk[2 * kk + 1][1];
            const bf16x8 y = __builtin_bit_cast(bf16x8, yv);
#pragma unroll
            for (int d = 0; d < 4; ++d) { const LAS unsigned short* vp = vT + (16 * (4 * h2 + d) + fr) * 72 + 32 * kk + 4 * fq;
                const v2u lo = *(const LAS v2u*)vp, hi = *(const LAS v2u*)(vp + 16);
                v4u xv; xv.x = lo.x; xv.y = lo.y; xv.z = hi.x; xv.w = hi.y;
                acc[d] = mfma16(__builtin_bit_cast(bf16x8, xv), y, acc[d]); } }
        { float ssq = 0.f;
#pragma unroll
          for (int d = 0; d < 4; ++d) ssq += (acc[d][0] * acc[d][0] + acc[d][1] * acc[d][1]) + (acc[d][2] * acc[d][2] + acc[d][3] * acc[d][3]);
          ssq = xor_add(xor_add(ssq, lane, 16), lane, 32);
          if (fq == 0) PS[h2 * 64 + 16 * wi + fr] = ssq; }
        wg_barrier();
        { const float tot = PS[16 * wi + fr] + PS[64 + 16 * wi + fr], rs = 1.0f / sqrtf(tot * (1.0f / HD) + EPS);
          const size_t row = crow0 + 16 * wi + fr;
#pragma unroll
          for (int d = 0; d < 4; ++d) { const int c0 = h * 128 + 16 * (4 * h2 + d) + 4 * fq;
              const f4 g = *(const f4*)(hn + c0); const v2u og = *(const v2u*)(OGs + row * HG + c0);
              v2u o; o.x = pkc(acc[d][0] * rs * g[0] * bflo(og.x), acc[d][1] * rs * g[1] * bfhi(og.x)); o.y = pkc(acc[d][2] * rs * g[2] * bflo(og.y), acc[d][3] * rs * g[3] * bfhi(og.y));
              *(v2u*)(hout + row * HG + c0) = o; } }
        wg_barrier();
    }
}

constexpr int PH_PER_LAYER = 11, N_PHASES = 1 + DEPTH * PH_PER_LAYER + 1;
enum { K_GU1 = 0, K_DOWN1, K_WIN, K_MIXA, K_SCAN, K_MIXC, K_PROJ, K_OUT, K_GU2, K_DOWN2, K_CONV };

__global__ void __launch_bounds__(NWAVES * 64, 2) enc_fwd(Args args) {
    extern __shared__ __attribute__((aligned(16))) unsigned char lds_raw[];
    LAS unsigned char* lds = (LAS unsigned char*)lds_raw;
    volatile LAS unsigned* MISC = (volatile LAS unsigned*)(lds + MISC_OFF);
    const int G = gridDim.x, bx = blockIdx.x, vcu = (G % 8 == 0) ? (bx % 8) * (G / 8) + bx / 8 : bx;
    unsigned char* const ws0 = args.ws;
    const int tid0 = threadIdx.x, wave0 = __builtin_amdgcn_readfirstlane(tid0 >> 6);
    { for (int u = tid0; u < (LDS_BYTES - LDSCTL_OFF) / 4; u += NWAVES * 64) ((LAS unsigned*)(lds + LDSCTL_OFF))[u] = 0u; }
    __syncthreads();
    XcdBarrier bar; bar.bar = (unsigned*)(ws0 + WS_CTL) + CW_BAR; bar.x = 0; bar.st = nullptr;
    bar = xcd_barrier_post((unsigned*)(ws0 + WS_CTL) + CW_BAR, MISC + 8);
    const int nph = args.nph;
#define WSP(T, off) ((T*)(ws + (off)))
#pragma unroll 1
    for (int pi = 0; pi < nph; ++pi) {
        unsigned char* ws = ws0; asm volatile("" : "+s"(ws));
        int zz = 0; asm volatile("" : "+v"(zz));
        const int lane = (int)__builtin_amdgcn_mbcnt_hi(~0u, __builtin_amdgcn_mbcnt_lo(~0u, (unsigned)zz)), NGW = G * NWAVES;
        int wave = wave0; asm volatile("" : "+s"(wave));
        const int gw = vcu * NWAVES + wave, tid = wave * 64 + lane;
        const int code = args.plist[pi] & 127, dry = args.plist[pi] >> 7, l = (code >> 4) - 1, k = code & 15;
        if (code == 0) {
            convert_weights(args, 0, lds, gw, NGW, wave, lane); x_to_bf16_ss(args.in[0], WSP(bf16, WS_XB), WSP(float, WS_SS), gw, NGW, lane);
        } else if (code == 1) {
            final_norm(args.out, args.in[18], gw, NGW, lane);
        } else if (k == K_GU1 || k == K_GU2) {
            pg8::StaticOrder S; S.init(WSP(bf16, WS_XB), ws + (k == K_GU1 ? WS_WGU1 : WS_WGU2), M, 2 * FF, D, G, bx); EpiGU E{WSP(bf16, WS_ACT), WSP(float, WS_SS), dry};
            pg8::gemm_phase<EpiGU, pg8::StaticOrder, true, true>(lds + RING_OFF, D, S, E, tid, pg8::stagger_ticks(S.T, STAG_DL, STAG_DS));
        } else if (k == K_DOWN1 || k == K_DOWN2 || k == K_OUT) {
            const bool isout = (k == K_OUT); const int KK = isout ? D : FF;
            pg8::StaticOrder S; S.init(isout ? WSP(bf16, WS_MERGED) : WSP(bf16, WS_ACT), ws + (isout ? WS_WOUT : (k == K_DOWN1 ? WS_WD1 : WS_WD2)), M, D, KK, G, bx);
            EpiX E{(l == 0 && k == K_DOWN1 && !dry) ? args.in[0] : args.out, args.out, WSP(bf16, WS_XB), WSP(float, WS_SS), dry ? 0.0f : (isout ? 1.0f : 0.5f)};
            pg8::gemm_phase<EpiX, pg8::StaticOrder, false, true>(lds + RING_OFF, KK, S, E, tid);
        } else if (k == K_WIN) {
            pg8::StaticOrder S; S.init(WSP(bf16, WS_XB), ws + WS_WIN, M, DIN, D, G, bx); EpiWin E{ws, WSP(float, WS_SS)};
            pg8::gemm_phase<EpiWin, pg8::StaticOrder, true, true>(lds + RING_OFF, D, S, E, tid, pg8::stagger_ticks(S.T, STAG_DL, STAG_DS));
        } else if (k == K_MIXA) {
            pool_items(WSP(bf16, WS_UPOOL), WSP(bf16, WS_POOLW), args.in[8] + l * PW, WSP(bf16, WS_POOLOUT), lds + RING_OFF, vcu, G, tid);
            hgrn_u_items(WSP(bf16, WS_F), WSP(bf16, WS_V), args.in[9], l, WSP(bf16, WS_XB), WSP(float, WS_DEC), lds + RING_OFF, vcu, G, tid);
        } else if (k == K_SCAN) {
            hgrn_scan(WSP(bf16, WS_XB), WSP(float, WS_DEC), vcu, tid);
        } else if (k == K_MIXC) {
            hgrn_o_items(WSP(bf16, WS_Q), WSP(bf16, WS_F), WSP(bf16, WS_V), WSP(bf16, WS_OG), args.in[9], args.in[10] + l * HG, l, WSP(bf16, WS_XB), WSP(bf16, WS_HOUT), lds + RING_OFF, vcu, G, tid);
        } else if (k == K_PROJ) {
            pg8::PairOrder S; S.init(WSP(bf16, WS_POOLOUT), ws + WS_WPA, WSP(bf16, WS_HOUT), ws + WS_WPB, M, D, PW, G, bx); EpiProj E{WSP(bf16, WS_GATES), WSP(bf16, WS_MERGED)};
            pg8::gemm_phase<EpiProj, pg8::PairOrder, true, true>(lds + RING_OFF, PW, S, E, tid);
        } else {
            __syncthreads(); convert_weights(args, l + 1, lds, gw, NGW, wave, lane);
        }
        if (pi + 1 < nph) { XcdBarrier bl = bar; asm volatile("" : "+s"(bl.bar)); xcd_barrier(bl); }
    }
#undef WSP
}

extern "C" void kernel_launch(void* const* d_in, const int* in_sizes, int n_in, void* d_out, int out_size, void* d_ws, size_t ws_size, hipStream_t stream) {
    static int grid = 0;
    if (grid == 0) {
        if (n_in != 19 || in_sizes[0] != M * D || out_size != M * D || ws_size < WS_END) { fprintf(stderr, "kernel_launch: unexpected shapes (n_in %d, in0 %d, out %d, ws %zu); nothing launched\n", n_in, n_in > 0 ? in_sizes[0] : -1, out_size, ws_size); grid = -1; return; }
        int dev = 0, cus = 0, per_cu = 0;
        if (hipGetDevice(&dev) != hipSuccess || hipDeviceGetAttribute(&cus, hipDeviceAttributeMultiprocessorCount, dev) != hipSuccess) { grid = -1; return; }
        if (hipFuncSetAttribute((const void*)enc_fwd, hipFuncAttributeMaxDynamicSharedMemorySize, LDS_BYTES) != hipSuccess) { fprintf(stderr, "kernel_launch: hipFuncSetAttribute failed\n"); grid = -1; return; }
        if (hipOccupancyMaxActiveBlocksPerMultiprocessor(&per_cu, (const void*)enc_fwd, NWAVES * 64, LDS_BYTES) != hipSuccess || per_cu < 1)
            fprintf(stderr, "kernel_launch: note: occupancy query reports %d workgroups per CU\n", per_cu);
        (void)hipGetLastError();
        grid = cus;
        if (grid != 256) fprintf(stderr, "kernel_launch: %d CUs; this kernel is laid out for 256\n", grid);
    }
    if (grid < 0) return;
    (void)hipMemsetAsync((char*)d_ws + WS_CTL, 0, CTL_ZERO_BYTES, stream);
    Args a{};
    for (int i = 0; i < 19; ++i) a.in[i] = (const float*)d_in[i];
    a.out = (float*)d_out; a.ws = (unsigned char*)d_ws;
    int n = 0; a.plist[n++] = 0;
    for (int l = 0; l < DEPTH; ++l) for (int k = 0; k <= K_CONV; ++k) { if (k == K_CONV && l + 1 >= DEPTH) continue; const unsigned char c = (unsigned char)(16 * (l + 1) + k); a.plist[n++] = c; if ((DBL_MASK >> k) & 1) a.plist[n++] = (unsigned char)(c | ((k == K_DOWN1 || k == K_DOWN2 || k == K_OUT || k == K_GU1 || k == K_GU2) ? 128 : 0)); }
    a.plist[n++] = 1; a.nph = n;
    hipLaunchKernelGGL(enc_fwd, dim3(grid), dim3(NWAVES * 64), LDS_BYTES, stream, a);
}
```
